# Optimizing an MI355X kernel written in HIP

```python
import jax
import jax.numpy as jnp
from jax import lax
import numpy as np


D_MODEL = 4096
BATCH = 1
SEQ = 16384
DEPTH = 4

GRID_W = 64
CTX_LEN = 256
HEAD_DIM = 128
N_HEADS_A = 16
N_KV_A = 4
N_HEADS_B = 8
WIN_H_MAX = 8
WIN_W = 16
N_GROUPS_C = 8
CHUNK = 128
Q_BLOCK = 128
D_FF = 6144
R_MOD = 256
N_MOD = 9
ROPE_THETA = 10000.0
EPS = 1e-6
W_A_Q = N_HEADS_A * HEAD_DIM
W_A_KV = N_KV_A * HEAD_DIM
W_B = N_HEADS_B * HEAD_DIM
W_C = N_GROUPS_C * HEAD_DIM
IN_COLS = W_A_Q + 2 * W_A_KV + 3 * W_B + 2 * W_C
MIX_W = W_A_Q + W_B + W_C

kernel_name = 'hybrid_dit_parallel_head_groups'


def rms_norm(x, g):
    xf = x.astype(jnp.float32)
    y = xf * lax.rsqrt(jnp.mean(xf * xf, axis=-1, keepdims=True) + EPS)
    return (y * g.astype(jnp.float32)).astype(x.dtype)


def modulated_norm(x, g, shift, scale):
    return rms_norm(x, g) * (1.0 + scale) + shift


def adaln(cond, w_down, w_up, b_up):
    m = (jax.nn.silu(cond) @ w_down) @ w_up + b_up
    return [t[:, None, :] for t in jnp.split(m, N_MOD, axis=-1)]


def ffn_half_step(x, g, shift, scale, gate, w_in, w_out):
    a, b = jnp.split(modulated_norm(x, g, shift, scale) @ w_in, 2, axis=-1)
    return x + 0.5 * gate * ((jax.nn.silu(a) * b) @ w_out)


def axial_rope_tables(n_tokens):
    t = jnp.arange(n_tokens, dtype=jnp.int32)
    row = (t // GRID_W).astype(jnp.float32)
    col = (t % GRID_W).astype(jnp.float32)
    half = HEAD_DIM // 2
    inv = ROPE_THETA ** (-jnp.arange(0, half, 2, dtype=jnp.float32) / half)
    ang_r = row[:, None] * inv[None, :]
    ang_c = col[:, None] * inv[None, :]
    ang = jnp.concatenate([ang_r, ang_r, ang_c, ang_c], axis=-1)
    return jnp.cos(ang), jnp.sin(ang)


def apply_axial_rope(x, cos, sin):
    xr = x.reshape(x.shape[:-1] + (2, 2, HEAD_DIM // 4))
    rot = jnp.stack([-xr[..., 1, :], xr[..., 0, :]], axis=-2).reshape(x.shape)
    return (x * cos[None, :, None, :] + rot * sin[None, :, None, :]).astype(x.dtype)


def neighbourhood_tables(n_tokens):
    rows = n_tokens // GRID_W
    kh = min(WIN_H_MAX, rows)
    t = jnp.arange(n_tokens, dtype=jnp.int32)
    r = t // GRID_W
    col = t % GRID_W
    r0 = jnp.clip(r - kh // 2, 0, rows - kh)
    c0 = jnp.clip(col - WIN_W // 2, 0, GRID_W - WIN_W)
    kr = r0[:, None, None] + jnp.arange(kh, dtype=jnp.int32)[None, :, None]
    kc = c0[:, None, None] + jnp.arange(WIN_W, dtype=jnp.int32)[None, None, :]
    shape = (n_tokens, kh, WIN_W)
    key_idx = jnp.broadcast_to(kr * GRID_W + kc, shape).reshape(n_tokens, kh * WIN_W)
    off_r = jnp.broadcast_to(kr - r[:, None, None] + (WIN_H_MAX - 1), shape).reshape(n_tokens, kh * WIN_W)
    off_c = jnp.broadcast_to(kc - col[:, None, None] + (WIN_W - 1), shape).reshape(n_tokens, kh * WIN_W)
    return key_idx, off_r, off_c


def heads(t, n):
    return t.reshape(t.shape[:-1] + (n, HEAD_DIM))


def split_projection(proj):
    sizes = (W_A_Q, W_A_KV, W_A_KV, W_B, W_B, W_B, W_C, W_C)
    idx = [sum(sizes[:j]) for j in range(1, len(sizes))]
    return jnp.split(proj, idx, axis=-1)


def gqa_softmax_attn(q, k, v):
    b, t, h, hd = q.shape
    g = k.shape[2]
    qg = q.reshape(b, t, g, h // g, hd)
    s = jnp.einsum('bqgrd,bkgd->bgrqk', qg, k, preferred_element_type=jnp.float32) * hd ** -0.5
    p = jax.nn.softmax(s, axis=-1).astype(v.dtype)
    o = jnp.einsum('bgrqk,bkgd->bqgrd', p, v)
    return o.reshape(b, t, h * hd)


def global_attn_blocked(q, k_all, v_all):
    b, s, h, hd = q.shape
    nblk = s // Q_BLOCK
    qb = q.reshape(b, nblk, Q_BLOCK, h, hd).swapaxes(0, 1)
    o = lax.map(lambda qi: gqa_softmax_attn(qi, k_all, v_all), qb)
    return o.swapaxes(0, 1).reshape(b, s, h * hd)


def neighbourhood_attn(q, k, v, k_ctx, v_ctx, rpb, key_idx, off_r, off_c):
    b, s, h, hd = q.shape
    nblk = s // Q_BLOCK
    n_win = key_idx.shape[-1]
    qb = q.reshape(b, nblk, Q_BLOCK, h, hd).swapaxes(0, 1)

    def blocks(a):
        return a.reshape(nblk, Q_BLOCK, n_win)

    def one_block(args):
        qi, idx, o_r, o_c = args
        kg = jnp.take(k, idx, axis=1)
        vg = jnp.take(v, idx, axis=1)
        s_win = (jnp.einsum('bqhd,bqkhd->bhqk', qi, kg, preferred_element_type=jnp.float32) * hd ** -0.5
                 + rpb[:, o_r, o_c].astype(jnp.float32))
        s_ctx = jnp.einsum('bqhd,bkhd->bhqk', qi, k_ctx, preferred_element_type=jnp.float32) * hd ** -0.5
        p = jax.nn.softmax(jnp.concatenate([s_win, s_ctx], axis=-1), axis=-1).astype(v.dtype)
        return (jnp.einsum('bhqk,bqkhd->bqhd', p[..., :n_win], vg)
                + jnp.einsum('bhqk,bkhd->bqhd', p[..., n_win:], v_ctx))

    o = lax.map(one_block, (qb, blocks(key_idx), blocks(off_r), blocks(off_c)))
    return o.swapaxes(0, 1).reshape(b, s, h * hd)


def spatial_gating(u, v, g_v, w_s, b_s):
    b, t, _ = u.shape
    n = t // CHUNK
    vn = rms_norm(heads(v, N_GROUPS_C), g_v.reshape(N_GROUPS_C, HEAD_DIM))
    vc = vn.reshape(b, n, CHUNK, N_GROUPS_C, HEAD_DIM)
    sv = jnp.einsum('gpq,bnqgc->bnpgc', w_s, vc) + b_s.T[:, :, None]
    return (u.reshape(b, n, CHUNK, N_GROUPS_C, HEAD_DIM) * sv).reshape(b, t, W_C)


def hybrid_mixer(h, hc, w_in, w_out, g_q, g_k, rpb, g_v, w_s, b_s,
                 rope_cos, rope_sin, key_idx, off_r, off_c, need_ctx_out):
    qa, ka, va, qb, kb, vb, u, v = split_projection(h @ w_in)
    qa_c, ka_c, va_c, qb_c, kb_c, vb_c, u_c, v_c = split_projection(hc @ w_in)
    qa = apply_axial_rope(rms_norm(heads(qa, N_HEADS_A), g_q), rope_cos, rope_sin)
    ka = apply_axial_rope(rms_norm(heads(ka, N_KV_A), g_k), rope_cos, rope_sin)
    ka_c = rms_norm(heads(ka_c, N_KV_A), g_k)
    va_c = heads(va_c, N_KV_A)
    k_all = jnp.concatenate([ka, ka_c], axis=1)
    v_all = jnp.concatenate([heads(va, N_KV_A), va_c], axis=1)
    o_a = global_attn_blocked(qa, k_all, v_all)
    kb_c = heads(kb_c, N_HEADS_B)
    vb_c = heads(vb_c, N_HEADS_B)
    o_b = neighbourhood_attn(heads(qb, N_HEADS_B), heads(kb, N_HEADS_B), heads(vb, N_HEADS_B),
                             kb_c, vb_c, rpb, key_idx, off_r, off_c)
    o_c = spatial_gating(jax.nn.gelu(u), jax.nn.gelu(v), g_v, w_s, b_s)
    y = jnp.concatenate([o_a, o_b, o_c], axis=-1) @ w_out
    if not need_ctx_out:
        return y, None
    o_a_c = gqa_softmax_attn(rms_norm(heads(qa_c, N_HEADS_A), g_q), ka_c, va_c)
    o_b_c = gqa_softmax_attn(heads(qb_c, N_HEADS_B), kb_c, vb_c)
    o_c_c = spatial_gating(jax.nn.gelu(u_c), jax.nn.gelu(v_c), g_v, w_s, b_s)
    yc = jnp.concatenate([o_a_c, o_b_c, o_c_c], axis=-1) @ w_out
    return y, yc


def setup_inputs(seed: int = 0) -> dict:
    key = jax.random.key(seed)
    ks = jax.random.split(key, 18)

    def nrm(k, shape, s):
        return jax.random.normal(k, shape, jnp.float32) * s

    return {
        'x': nrm(ks[0], (BATCH, SEQ, D_MODEL), 1.0),
        'c': nrm(ks[1], (BATCH, D_MODEL), 1.0),
        'ctx': nrm(ks[2], (BATCH, CTX_LEN, D_MODEL), 1.0),
        'c_ctx': nrm(ks[3], (D_MODEL,), 1.0),
        'norm_g': 1.0 + nrm(ks[4], (DEPTH, 3, D_MODEL), 0.02),
        'mod_w_down': nrm(ks[5], (DEPTH, D_MODEL, R_MOD), D_MODEL ** -0.5),
        'mod_w_up': nrm(ks[6], (DEPTH, R_MOD, N_MOD * D_MODEL), 0.5 * R_MOD ** -0.5),
        'mod_b': nrm(ks[7], (DEPTH, N_MOD * D_MODEL), 0.02),
        'ffn_w_in': nrm(ks[8], (DEPTH, 2, D_MODEL, 2 * D_FF), D_MODEL ** -0.5),
        'ffn_w_out': nrm(ks[9], (DEPTH, 2, D_FF, D_MODEL), D_FF ** -0.5),
        'mix_w_in': nrm(ks[10], (DEPTH, D_MODEL, IN_COLS), D_MODEL ** -0.5),
        'mix_w_out': nrm(ks[11], (DEPTH, MIX_W, D_MODEL), MIX_W ** -0.5),
        'qk_norm_g': 1.0 + nrm(ks[12], (DEPTH, 2, HEAD_DIM), 0.02),
        'rpb': nrm(ks[13], (DEPTH, N_HEADS_B, 2 * WIN_H_MAX - 1, 2 * WIN_W - 1), 0.1),
        'sgu_norm_g': 1.0 + nrm(ks[14], (DEPTH, W_C), 0.02),
        'sgu_w': nrm(ks[15], (DEPTH, N_GROUPS_C, CHUNK, CHUNK), CHUNK ** -0.5),
        'sgu_b': 1.0 + nrm(ks[16], (DEPTH, N_GROUPS_C, CHUNK), 0.02),
        'final_norm_g': 1.0 + nrm(ks[17], (D_MODEL,), 0.02),
    }


def reference(x, c, ctx, c_ctx, norm_g, mod_w_down, mod_w_up, mod_b, ffn_w_in, ffn_w_out,
              mix_w_in, mix_w_out, qk_norm_g, rpb, sgu_norm_g, sgu_w, sgu_b, final_norm_g):
    n_tok = x.shape[1]
    rope_cos, rope_sin = axial_rope_tables(n_tok)
    key_idx, off_r, off_c = neighbourhood_tables(n_tok)
    xc = ctx
    for i in range(DEPTH):
        last = i == DEPTH - 1
        m = adaln(c, mod_w_down[i], mod_w_up[i], mod_b[i])
        mc = adaln(c_ctx[None, :], mod_w_down[i], mod_w_up[i], mod_b[i])
        x = ffn_half_step(x, norm_g[i, 0], m[0], m[1], m[2], ffn_w_in[i, 0], ffn_w_out[i, 0])
        xc = ffn_half_step(xc, norm_g[i, 0], mc[0], mc[1], mc[2], ffn_w_in[i, 0], ffn_w_out[i, 0])
        h = modulated_norm(x, norm_g[i, 1], m[3], m[4])
        hc = modulated_norm(xc, norm_g[i, 1], mc[3], mc[4])
        y, yc = hybrid_mixer(h, hc, mix_w_in[i], mix_w_out[i], qk_norm_g[i, 0], qk_norm_g[i, 1],
                             rpb[i], sgu_norm_g[i], sgu_w[i], sgu_b[i], rope_cos, rope_sin,
                             key_idx, off_r, off_c, not last)
        x = x + m[5] * y
        x = ffn_half_step(x, norm_g[i, 2], m[6], m[7], m[8], ffn_w_in[i, 1], ffn_w_out[i, 1])
        if not last:
            xc = xc + mc[5] * yc
            xc = ffn_half_step(xc, norm_g[i, 2], mc[6], mc[7], mc[8], ffn_w_in[i, 1], ffn_w_out[i, 1])
    return rms_norm(x, final_norm_g)
```

```cpp
#include <hip/hip_runtime.h>
#include <cstdio>
#include <cstdint>
namespace pg8 {
#define PG8_LAS __attribute__((address_space(3)))
typedef unsigned short bf16_t;
typedef short bf16x8 __attribute__((ext_vector_type(8)));
typedef float f32x4 __attribute__((ext_vector_type(4)));
typedef unsigned u32x4 __attribute__((ext_vector_type(4)));
constexpr int BM = 256, BK = 64, HALF = 128, HTB = HALF * BK * 2  , STAGE_BYTES = 8 * HTB, NXCD = 8, WGM = 8;

__host__ __device__ __forceinline__ int lds_byte(int r, int c) { const int st = (r >> 4) * 2 + (c >> 5), rr = r & 15, cc = c & 31, ob = rr * 64 + cc * 2; return st * 1024 + (ob ^ (((ob >> 9) & 1) << 5)); }
__host__ __device__ __forceinline__ void stage_rc(int b, int& R, int& C) { const int st = b / 1024, sb = b % 1024, swz = sb ^ (((sb >> 9) & 1) << 5); R = (st >> 1) * 16 + swz / 64; C = (st & 1) * 32 + (swz % 64) / 2; }
__host__ __device__ __forceinline__ int perm32(int rho) { const int n = rho >> 4, i = rho & 15; return 8 * (i >> 2) + 4 * n + (i & 3); }

struct Unit { int pm, pn; };
struct Gemm { const bf16_t* A; const bf16_t* Bt; int M, N, K; };

struct StaticOrder {
    int nM, nN, nwg, G, c;
    __host__ __device__ void init(int M, int N, int G_, int c_) { nM = M / BM; nN = N / BM; nwg = nM * nN; G = G_; c = c_; }
    __host__ __device__ bool next(int i, Unit& u) const {
        const long L = (long)i * G + c; if (L >= nwg) return false;
        int wgid = (int)L; { const int q = nwg / NXCD, r = nwg % NXCD, xcd = wgid % NXCD, off = wgid / NXCD; wgid = (xcd < r ? xcd * (q + 1) : r * (q + 1) + (xcd - r) * q) + off; }
        const int nig = WGM * nN, gid = wgid / nig, fm = gid * WGM, gsz = (nM - fm) < WGM ? (nM - fm) : WGM;
        u.pm = fm + ((wgid % nig) % gsz); u.pn = (wgid % nig) / gsz; return true;
    }
    __device__ __forceinline__ void a_ready(const Unit&) const {}
    __device__ __forceinline__ void done(const Unit&) const {}
};

__device__ __forceinline__ unsigned cvt_pk_bf16(float lo, float hi) { unsigned r; asm volatile("v_cvt_pk_bf16_f32 %0, %1, %2" : "=v"(r) : "v"(lo), "v"(hi)); return r; }
typedef float f32x2 __attribute__((ext_vector_type(2)));
__device__ __forceinline__ f32x2 gelu_pk(f32x2 v) {
    const f32x2 av = __builtin_elementwise_abs(v), d = av * 0.2316418882f + 1.0f;
    f32x2 t; t.x = __builtin_amdgcn_rcpf(d.x); t.y = __builtin_amdgcn_rcpf(d.y);
    f32x2 q = t * 0.5307027145f + (-0.7265760135f); q = q * t + 0.7107068705f; q = q * t + (-0.142248368f); q = q * t + 0.127414796f; q = q * t;
    const f32x2 s = (v * v) * (-0.72134752044f);
    f32x2 e; e.x = __builtin_amdgcn_exp2f(s.x); e.y = __builtin_amdgcn_exp2f(s.y);
    const f32x2 m = v * (q * e), r = v - m;
    f32x2 o; o.x = v.x < 0.f ? m.x : r.x; o.y = v.y < 0.f ? m.y : r.y; return o;
}

template <int ACT  > struct EpiBf16 {
    static constexpr bool PERM = true, AFTER_DRAIN = false; static_assert(ACT == 0 || ACT == 1, "EpiBf16: ACT is 0 (none) or 1 (gelu_pk)");
    bf16_t* O; int ldc; const float* bias; int split_cols; size_t split_stride; float scale0;
    __device__ __forceinline__ void operator()(const f32x4 (&acc)[2][2][4][2], const Unit& u, int wr, int wc, int fr, int fq) const {
        const int row0 = u.pm * BM + wr * 64 + fr; int colt = u.pn * BM; bf16_t* base = O;
        float sc = 1.f; if (split_cols) { const int t = colt / split_cols; base += (size_t)t * split_stride; colt -= t * split_cols; if (t == 0) sc = scale0; }
        const int col0 = colt + wc * 32 + 8 * fq, bcol0 = u.pn * BM + wc * 32 + 8 * fq;
        f32x4 bv[2][2];
#pragma unroll
        for (int bj = 0; bj < 2; ++bj)
#pragma unroll
            for (int n = 0; n < 2; ++n) bv[bj][n] = bias ? *(const f32x4*)(bias + bcol0 + bj * HALF + 4 * n) : (f32x4){0.f, 0.f, 0.f, 0.f};
#pragma unroll
        for (int ai = 0; ai < 2; ++ai)
#pragma unroll
            for (int m = 0; m < 4; ++m) { bf16_t* rowp = base + (size_t)(row0 + ai * HALF + m * 16) * ldc + col0;
#pragma unroll
                for (int bj = 0; bj < 2; ++bj) { f32x4 v0 = acc[ai][bj][m][0] + bv[bj][0], v1 = acc[ai][bj][m][1] + bv[bj][1];
                    if (ACT == 1) { f32x2 a = gelu_pk((f32x2){v0[0], v0[1]}), b = gelu_pk((f32x2){v0[2], v0[3]}), c = gelu_pk((f32x2){v1[0], v1[1]}), d = gelu_pk((f32x2){v1[2], v1[3]});
                        v0 = (f32x4){a.x, a.y, b.x, b.y}; v1 = (f32x4){c.x, c.y, d.x, d.y}; }
                    v0 = v0 * sc; v1 = v1 * sc; u32x4 w; w.x = cvt_pk_bf16(v0[0], v0[1]); w.y = cvt_pk_bf16(v0[2], v0[3]); w.z = cvt_pk_bf16(v1[0], v1[1]); w.w = cvt_pk_bf16(v1[2], v1[3]);
                    *(u32x4*)(rowp + bj * HALF) = w; } }
    }
};

struct EpiSwiGLU {
    static constexpr bool PERM = true, AFTER_DRAIN = false;
    bf16_t* O; int ldc;
    __device__ __forceinline__ void operator()(const f32x4 (&acc)[2][2][4][2], const Unit& u, int wr, int wc, int fr, int fq) const {
        const int row0 = u.pm * BM + wr * 64 + fr, col0 = u.pn * HALF + wc * 32 + 8 * fq;
#pragma unroll
        for (int ai = 0; ai < 2; ++ai)
#pragma unroll
            for (int m = 0; m < 4; ++m) {
                bf16_t* rowp = O + (size_t)(row0 + ai * HALF + m * 16) * ldc + col0;
                float r[8];
#pragma unroll
                for (int n = 0; n < 2; ++n)
#pragma unroll
                    for (int e = 0; e < 4; ++e) { const float a = acc[ai][0][m][n][e], b = acc[ai][1][m][n][e];
                        const float s = __builtin_amdgcn_rcpf(1.f + __builtin_amdgcn_exp2f(a * -1.4426950408889634f)); r[n * 4 + e] = (a * s) * b; }
                u32x4 w; w.x = cvt_pk_bf16(r[0], r[1]); w.y = cvt_pk_bf16(r[2], r[3]); w.z = cvt_pk_bf16(r[4], r[5]); w.w = cvt_pk_bf16(r[6], r[7]);
                *(u32x4*)rowp = w; }
    }
};
struct EpiResid {
    static constexpr bool PERM = false, AFTER_DRAIN = false;
    float* X; int ldc; const float* gate; const float* gate_c; int ctx_pm; float gs;
    __device__ __forceinline__ void operator()(const f32x4 (&acc)[2][2][4][2], const Unit& u, int wr, int wc, int fr, int fq) const {
        const int row0 = u.pm * BM + wr * 64 + fr, col0 = u.pn * BM + wc * 32 + 4 * fq;
        const float* gp = (u.pm >= ctx_pm) ? gate_c : gate;
        f32x4 gv[2][2];
#pragma unroll
        for (int bj = 0; bj < 2; ++bj)
#pragma unroll
            for (int n = 0; n < 2; ++n) gv[bj][n] = *(const f32x4*)(gp + col0 + bj * HALF + n * 16) * gs;
#pragma unroll
        for (int ai = 0; ai < 2; ++ai)
#pragma unroll
            for (int m = 0; m < 4; ++m) { float* rowp = X + (size_t)(row0 + ai * HALF + m * 16) * ldc + col0;
#pragma unroll
                for (int bj = 0; bj < 2; ++bj)
#pragma unroll
                    for (int n = 0; n < 2; ++n) { f32x4* p = (f32x4*)(rowp + bj * HALF + n * 16); *p = *p + gv[bj][n] * acc[ai][bj][m][n]; } }
    }
};

template <class Epi, class Sched, bool ALIGN_EPI = false, bool SP2 = false>
__device__ __forceinline__ void gemm_phase(PG8_LAS unsigned char* lds, const Gemm g, const Sched& S, const Epi& E) {
    int tid_ = threadIdx.x; asm volatile("" : "+v"(tid_));
    const int tid = tid_, wid = __builtin_amdgcn_readfirstlane(tid >> 6), lane = tid & 63, wr = wid >> 2, wc = wid & 3, fr = lane & 15, fq = lane >> 4;
    const int K = g.K, nt = K / BK;
    unsigned voffA[2], voffB[2];
#pragma unroll
    for (int i = 0; i < 2; ++i) { int R, C; stage_rc(tid * 16 + i * 8192, R, C); const int Rb = Epi::PERM ? ((R & ~31) + perm32(R & 31)) : R;
        voffA[i] = (unsigned)(R * K + C) * 2u; voffB[i] = (unsigned)(Rb * K + C) * 2u; }
    const size_t kstep = (size_t)(BK * 2);
    const size_t hstep = (size_t)HALF * K * 2;
    const size_t tstep = 2 * hstep;
    const unsigned ldsw = (unsigned)wid * 1024u;
    const int aoff = lds_byte(wr * 64 + fr, fq * 8), boff = lds_byte(wc * 32 + fr, fq * 8);
#define PG8_SA(b, h) (((b) * 2 + (h)) * HTB)
#define PG8_SB(b, h) ((4 + (b) * 2 + (h)) * HTB)
#define PG8_STAGE(bufoff, gbase, voff) do { _Pragma("unroll") for (int _i = 0; _i < 2; ++_i) \
        __builtin_amdgcn_global_load_lds((const unsigned*)((const char*)(gbase) + (voff)[_i]), (PG8_LAS unsigned*)(lds + (bufoff) + ldsw + _i * 8192), 16, 0, 0); } while (0)
#define PG8_LDA(dst, b, h) do { _Pragma("unroll") for (int m = 0; m < 4; ++m) _Pragma("unroll") for (int k = 0; k < 2; ++k) dst[m][k] = *(const PG8_LAS bf16x8*)(lds + PG8_SA(b, h) + aoff + m * 2048 + k * 1024); } while (0)
#define PG8_LDB(dst, b, h) do { _Pragma("unroll") for (int n = 0; n < 2; ++n) _Pragma("unroll") for (int k = 0; k < 2; ++k) dst[n][k] = *(const PG8_LAS bf16x8*)(lds + PG8_SB(b, h) + boff + n * 2048 + k * 1024); } while (0)
#define PG8_MMA(ai, bj, At, Bt) do { __builtin_amdgcn_s_setprio(1); _Pragma("unroll") for (int m = 0; m < 4; ++m) _Pragma("unroll") for (int n = 0; n < 2; ++n) _Pragma("unroll") for (int k = 0; k < 2; ++k) \
        acc[ai][bj][m][n] = __builtin_amdgcn_mfma_f32_16x16x32_bf16(Bt[n][k], At[m][k], acc[ai][bj][m][n], 0, 0, 0); __builtin_amdgcn_s_setprio(0); } while (0)
#define PG8_WAIT_V(n) asm volatile("s_waitcnt vmcnt(" #n ")" ::: "memory")
#define PG8_WAIT_L(n) asm volatile("s_waitcnt lgkmcnt(" #n ")" ::: "memory")
#define PG8_BAR __builtin_amdgcn_s_barrier()
#define PG8_SCHED __builtin_amdgcn_sched_barrier(0)
    Unit cur, nxt; int ui = 0;
    if (!S.next(0, cur)) return;
    f32x4 acc[2][2][4][2];
#pragma unroll
    for (int a = 0; a < 2; ++a)
#pragma unroll
        for (int b = 0; b < 2; ++b)
#pragma unroll
            for (int m = 0; m < 4; ++m)
#pragma unroll
                for (int n = 0; n < 2; ++n) acc[a][b][m][n] = (f32x4){0.f, 0.f, 0.f, 0.f};
    bf16x8 At[4][2], B0[2][2], B1[2][2];
    const char* cA = (const char*)g.A + (size_t)cur.pm * tstep; const char* cB = (const char*)g.Bt + (size_t)cur.pn * tstep;
    S.a_ready(cur);
    if constexpr (SP2) {
        PG8_STAGE(PG8_SB(0, 0), cB, voffB); PG8_STAGE(PG8_SB(0, 1), cB + hstep, voffB); PG8_STAGE(PG8_SA(0, 0), cA, voffA); PG8_STAGE(PG8_SA(0, 1), cA + hstep, voffA);
        if (wr == 1) PG8_BAR;
        PG8_WAIT_V(2); PG8_BAR;
        PG8_STAGE(PG8_SB(1, 0), cB + kstep, voffB); PG8_STAGE(PG8_SA(1, 0), cA + kstep, voffA); PG8_STAGE(PG8_SB(1, 1), cB + hstep + kstep, voffB);
        PG8_WAIT_V(6); PG8_BAR;
    } else {
        PG8_STAGE(PG8_SB(0, 0), cB, voffB); PG8_STAGE(PG8_SA(0, 0), cA, voffA); PG8_STAGE(PG8_SB(0, 1), cB + hstep, voffB); PG8_STAGE(PG8_SA(0, 1), cA + hstep, voffA);
        if (wr == 1) PG8_BAR;
        PG8_WAIT_V(4); PG8_BAR;
        PG8_STAGE(PG8_SB(1, 0), cB + kstep, voffB); PG8_STAGE(PG8_SA(1, 0), cA + kstep, voffA); PG8_STAGE(PG8_SB(1, 1), cB + hstep + kstep, voffB);
        PG8_WAIT_V(6); PG8_BAR;
    }
    for (;;) {
        const bool has_next = S.next(ui + 1, nxt);
        const char* nA = has_next ? (const char*)g.A + (size_t)nxt.pm * tstep : cA; const char* nB = has_next ? (const char*)g.Bt + (size_t)nxt.pn * tstep : cB;
        for (int t = 0; t < nt; t += 2) {
            const bool last = (t == nt - 2);
            const char* a1 = cA + (size_t)(t + 1) * kstep;
            const char* a2 = last ? nA : cA + (size_t)(t + 2) * kstep; const char* b2 = last ? nB : cB + (size_t)(t + 2) * kstep;
            const char* a3 = a2 + kstep; const char* b3 = b2 + kstep;
            if (last && has_next) S.a_ready(nxt);
            if constexpr (SP2) {
            PG8_LDB(B0, 0, 0); PG8_LDB(B1, 0, 1); PG8_SCHED; PG8_LDA(At, 0, 0); PG8_STAGE(PG8_SA(1, 1), a1 + hstep, voffA);
            PG8_WAIT_V(8); PG8_WAIT_L(0); PG8_BAR; PG8_MMA(0, 0, At, B0); PG8_MMA(0, 1, At, B1); PG8_BAR; PG8_SCHED;
            PG8_LDA(At, 0, 1); PG8_STAGE(PG8_SB(0, 0), b2, voffB); PG8_STAGE(PG8_SB(0, 1), b2 + hstep, voffB); PG8_STAGE(PG8_SA(0, 0), a2, voffA);
            PG8_WAIT_V(8); PG8_WAIT_L(0); PG8_BAR; PG8_MMA(1, 0, At, B0); PG8_MMA(1, 1, At, B1); PG8_BAR; PG8_SCHED;
            PG8_LDB(B0, 1, 0); PG8_LDB(B1, 1, 1); PG8_SCHED; PG8_LDA(At, 1, 0); PG8_STAGE(PG8_SA(0, 1), a2 + hstep, voffA);
            PG8_WAIT_V(8); PG8_WAIT_L(0); PG8_BAR; PG8_MMA(0, 0, At, B0); PG8_MMA(0, 1, At, B1); PG8_BAR; PG8_SCHED;
            PG8_LDA(At, 1, 1); PG8_STAGE(PG8_SB(1, 0), b3, voffB); PG8_STAGE(PG8_SB(1, 1), b3 + hstep, voffB); PG8_STAGE(PG8_SA(1, 0), a3, voffA);
            PG8_WAIT_V(8); PG8_WAIT_L(0); PG8_BAR; PG8_MMA(1, 0, At, B0); PG8_MMA(1, 1, At, B1); PG8_BAR; PG8_SCHED;
            } else {
            PG8_LDB(B0, 0, 0); PG8_SCHED; PG8_LDA(At, 0, 0); PG8_STAGE(PG8_SA(1, 1), a1 + hstep, voffA);
            PG8_WAIT_L(8); PG8_BAR; PG8_WAIT_L(0); PG8_MMA(0, 0, At, B0); PG8_BAR; PG8_SCHED;
            PG8_LDB(B1, 0, 1); PG8_STAGE(PG8_SB(0, 0), b2, voffB);
            PG8_BAR; PG8_WAIT_L(0); PG8_MMA(0, 1, At, B1); PG8_BAR;
            PG8_LDA(At, 0, 1); PG8_STAGE(PG8_SA(0, 0), a2, voffA);
            PG8_BAR; PG8_WAIT_L(0); PG8_MMA(1, 0, At, B0); PG8_BAR; PG8_SCHED;
            PG8_STAGE(PG8_SB(0, 1), b2 + hstep, voffB);
            PG8_WAIT_V(6); PG8_BAR; PG8_MMA(1, 1, At, B1); PG8_BAR;
            PG8_LDB(B0, 1, 0); PG8_SCHED; PG8_LDA(At, 1, 0); PG8_STAGE(PG8_SA(0, 1), a2 + hstep, voffA);
            PG8_WAIT_L(8); PG8_BAR; PG8_WAIT_L(0); PG8_MMA(0, 0, At, B0); PG8_BAR; PG8_SCHED;
            PG8_LDB(B1, 1, 1); PG8_STAGE(PG8_SB(1, 0), b3, voffB);
            PG8_BAR; PG8_WAIT_L(0); PG8_MMA(0, 1, At, B1); PG8_BAR;
            PG8_LDA(At, 1, 1); PG8_STAGE(PG8_SA(1, 0), a3, voffA);
            PG8_BAR; PG8_WAIT_L(0); PG8_MMA(1, 0, At, B0); PG8_BAR; PG8_SCHED;
            PG8_STAGE(PG8_SB(1, 1), b3 + hstep, voffB);
            PG8_WAIT_V(6); PG8_BAR; PG8_MMA(1, 1, At, B1); PG8_BAR;
            }
        }
        if constexpr (ALIGN_EPI) { if (wr == 0) PG8_BAR; }
        if constexpr (!Epi::AFTER_DRAIN) { E(acc, cur, wr, wc, fr, fq); S.done(cur); }
        if (!has_next) break;
#pragma unroll
        for (int a = 0; a < 2; ++a)
#pragma unroll
            for (int b = 0; b < 2; ++b)
#pragma unroll
                for (int m = 0; m < 4; ++m)
#pragma unroll
                    for (int n = 0; n < 2; ++n) acc[a][b][m][n] = (f32x4){0.f, 0.f, 0.f, 0.f};
        cur = nxt; cA = nA; cB = nB; ++ui;
        if constexpr (ALIGN_EPI) { if (wr == 1) PG8_BAR; }
    }
    PG8_WAIT_V(0);
    if constexpr (!ALIGN_EPI) { if (wr == 0) PG8_BAR; }
    PG8_BAR;
    if constexpr (Epi::AFTER_DRAIN) { E.fused(acc, cur, wr, wc, fr, fq, lds, wid, lane); S.done(cur); }
#undef PG8_SA
#undef PG8_SB
#undef PG8_STAGE
#undef PG8_LDA
#undef PG8_LDB
#undef PG8_MMA
#undef PG8_WAIT_V
#undef PG8_WAIT_L
#undef PG8_BAR
#undef PG8_SCHED
}
}

namespace att {
typedef unsigned short bf16;
using bf16x8 = __attribute__((ext_vector_type(8))) short;
using s16x4  = __attribute__((ext_vector_type(4))) short;
using f32x16 = __attribute__((ext_vector_type(16))) float;
using u32x4  = __attribute__((ext_vector_type(4))) unsigned;
constexpr int   D = 128, NW = 8, QBLK = 32, KVBLK = 64;
constexpr float SCALE = 0.088388347648318440f;
constexpr float THR = 8.f;
constexpr size_t SHM_V = KVBLK * D * 2, SHM_K = KVBLK * D * 2, SHM_ATTN = 2 * SHM_V + 2 * SHM_K + NW * 64 * 4;
constexpr int RPB_OFF = (int)SHM_ATTN;
constexpr int NB_WIN_TILES = 12, SEQ_LAT = 16384;
#define KSWZ(row, colB) ((row) * 256 + ((colB) ^ (((row) & 7) << 4)))
#define SBAR() __builtin_amdgcn_sched_barrier(0)
__device__ __forceinline__ int crow(int r, int hi) { return (r & 3) + 8 * (r >> 2) + 4 * hi; }
__device__ __forceinline__ unsigned cvtpk(float lo, float hi) {
  unsigned r; asm volatile("v_cvt_pk_bf16_f32 %0, %1, %2" : "=v"(r) : "v"(lo), "v"(hi)); return r;
}
__device__ __forceinline__ void partialSM(f32x16& p0, f32x16& p1, float& m_reg, float& mn, float& alpha) {
  constexpr float C = SCALE * 1.4426950408889634f;
  float pmax = p0[0];
#pragma unroll
  for (int r = 1; r < 16; ++r) pmax = fmaxf(pmax, p0[r]);
#pragma unroll
  for (int r = 0; r < 16; ++r) pmax = fmaxf(pmax, p1[r]);
  { auto rr = __builtin_amdgcn_permlane32_swap(__float_as_uint(pmax), __float_as_uint(pmax), false, false);
    pmax = fmaxf(__uint_as_float(rr[0]), __uint_as_float(rr[1])); }
  if (__builtin_expect(__all(pmax - m_reg <= THR / SCALE), 1)) { mn = m_reg; alpha = 1.f; }
  else { mn = fmaxf(m_reg, pmax); alpha = __builtin_amdgcn_exp2f((m_reg - mn) * C); m_reg = mn; }
  float mnC = -mn * C;
#pragma unroll
  for (int r = 0; r < 16; ++r) p0[r] = fmaf(p0[r], C, mnC);
#pragma unroll
  for (int r = 0; r < 16; ++r) p1[r] = fmaf(p1[r], C, mnC);
#pragma unroll
  for (int r = 0; r < 16; ++r) p0[r] = __builtin_amdgcn_exp2f(p0[r]);
}
__device__ __forceinline__ void finishSM(f32x16& p0, f32x16& p1, float alpha, float& l_reg, bf16x8& pa0, bf16x8& pa1, bf16x8& pa2, bf16x8& pa3) {
#pragma unroll
  for (int r = 0; r < 16; ++r) p1[r] = __builtin_amdgcn_exp2f(p1[r]);
  float ps = 0;
#pragma unroll
  for (int r = 0; r < 16; ++r) ps += p0[r];
#pragma unroll
  for (int r = 0; r < 16; ++r) ps += p1[r];
  { auto rr = __builtin_amdgcn_permlane32_swap(__float_as_uint(ps), __float_as_uint(ps), false, false);
    ps = __uint_as_float(rr[0]) + __uint_as_float(rr[1]); }
  l_reg = l_reg * alpha + ps;
#define PK4(P, BASE, OUT) do { unsigned a0 = cvtpk(P[BASE + 0], P[BASE + 1]), a1 = cvtpk(P[BASE + 2], P[BASE + 3]);   \
    unsigned b0 = cvtpk(P[BASE + 4], P[BASE + 5]), b1 = cvtpk(P[BASE + 6], P[BASE + 7]);                              \
    auto r0 = __builtin_amdgcn_permlane32_swap(a0, b0, false, false); auto r1 = __builtin_amdgcn_permlane32_swap(a1, b1, false, false); \
    u32x4 w = {r0[0], r1[0], r0[1], r1[1]}; OUT = *reinterpret_cast<bf16x8*>(&w); } while (0)
  PK4(p0, 0, pa0); PK4(p0, 8, pa1); PK4(p1, 0, pa2); PK4(p1, 8, pa3);
#undef PK4
}
__device__ __forceinline__ void qkt(f32x16& p0, f32x16& p1, const char* Ks, const bf16x8* qr, int r32, int hi) {
  p0 = f32x16{}; p1 = f32x16{};
#pragma unroll
  for (int d0 = 0; d0 < 8; ++d0) { int cb = (d0 * 16 + hi * 8) * 2;
    bf16x8 b0 = *reinterpret_cast<const bf16x8*>(Ks + KSWZ(r32, cb));
    bf16x8 b1 = *reinterpret_cast<const bf16x8*>(Ks + KSWZ(32 + r32, cb));
    p0 = __builtin_amdgcn_mfma_f32_32x32x16_bf16(b0, qr[d0], p0, 0, 0, 0);
    p1 = __builtin_amdgcn_mfma_f32_32x32x16_bf16(b1, qr[d0], p1, 0, 0, 0); }
}
__device__ __forceinline__ int v_st(int k, int c) { const int kk = (k & ~0xC) | ((k & 4) << 1) | ((k & 8) >> 1); return ((kk >> 3) * 4 + (c >> 5)) * 512 + ((kk & 7) * 32 + (c & 31)) * 2; }
__device__ __forceinline__ int v_rd_base(int lane) { return ((lane & 3) << 3) | (((lane >> 2) & 3) << 6) | (((lane >> 4) & 1) << 5) | (((lane >> 5) & 1) << 8); }
constexpr int v_rd_off(int d0, int ks, int half) { return d0 * 512 + ks * 4096 + half * 2048; }
template <int OFF> __device__ __forceinline__ s16x4 tr_read(int vb) {
  s16x4 r; asm volatile("ds_read_b64_tr_b16 %0, %1 offset:%2" : "=&v"(r) : "v"(vb), "i"(OFF) : "memory"); return r;
}
template <int D0> __device__ __forceinline__ void pv_one(f32x16& od, int vb, bf16x8 pa0, bf16x8 pa1, bf16x8 pa2, bf16x8 pa3) {
  const s16x4 l0 = tr_read<v_rd_off(D0, 0, 0)>(vb), h0 = tr_read<v_rd_off(D0, 0, 1)>(vb), l1 = tr_read<v_rd_off(D0, 1, 0)>(vb), h1 = tr_read<v_rd_off(D0, 1, 1)>(vb);
  const s16x4 l2 = tr_read<v_rd_off(D0, 2, 0)>(vb), h2 = tr_read<v_rd_off(D0, 2, 1)>(vb), l3 = tr_read<v_rd_off(D0, 3, 0)>(vb), h3 = tr_read<v_rd_off(D0, 3, 1)>(vb);
  asm volatile("s_waitcnt lgkmcnt(0)" ::: "memory"); SBAR();
#define PK(L, H) (bf16x8){L[0], L[1], L[2], L[3], H[0], H[1], H[2], H[3]}
  od = __builtin_amdgcn_mfma_f32_32x32x16_bf16(pa0, PK(l0, h0), od, 0, 0, 0);
  od = __builtin_amdgcn_mfma_f32_32x32x16_bf16(pa1, PK(l1, h1), od, 0, 0, 0);
  od = __builtin_amdgcn_mfma_f32_32x32x16_bf16(pa2, PK(l2, h2), od, 0, 0, 0);
  od = __builtin_amdgcn_mfma_f32_32x32x16_bf16(pa3, PK(l3, h3), od, 0, 0, 0);
#undef PK
}
__device__ __forceinline__ void pv_d0(f32x16* o, int vb, bf16x8 pa0, bf16x8 pa1, bf16x8 pa2, bf16x8 pa3) {
  pv_one<0>(o[0], vb, pa0, pa1, pa2, pa3); pv_one<1>(o[1], vb, pa0, pa1, pa2, pa3); pv_one<2>(o[2], vb, pa0, pa1, pa2, pa3); pv_one<3>(o[3], vb, pa0, pa1, pa2, pa3);
}
__device__ __forceinline__ void nb_mask(f32x16& p0, f32x16& p1, int j, int lo, int qr_, int qc, int hi, const __attribute__((address_space(3))) float* rpbl) {
  if (j >= NB_WIN_TILES) return;
  const int kr = lo + j; int r0 = qr_ - 4; r0 = r0 < 0 ? 0 : (r0 > 248 ? 248 : r0);
  const float NEG = -INFINITY;
  if (kr < r0 || kr >= r0 + 8) {
#pragma unroll
    for (int x = 0; x < 16; ++x) { p0[x] = NEG; p1[x] = NEG; }
    return; }
  int c0 = qc - 8; c0 = c0 < 0 ? 0 : (c0 > 48 ? 48 : c0);
  const __attribute__((address_space(3))) float* row = rpbl + (kr - qr_ + 7) * 31 + 15 - qc;
#pragma unroll
  for (int x = 0; x < 16; ++x) {
    const int kc0 = crow(x, hi), kc1 = kc0 + 32;
    const bool v0 = (unsigned)(kc0 - c0) < 16u, v1 = (unsigned)(kc1 - c0) < 16u;
    const float b0 = row[v0 ? kc0 : qc], b1 = row[v1 ? kc1 : qc];
    p0[x] = v0 ? p0[x] + b0 : NEG; p1[x] = v1 ? p1[x] + b1 : NEG;
    if ((x & 3) == 3) SBAR(); }
}
struct NbArgs { int lo, qrow, qcol; const float* rpb_h; };

template <int MODE, int LDQ, int LDK, int LDO, int SDEPTH>
__device__ __forceinline__ void attn_unit(const bf16* __restrict__ Qb, const bf16* __restrict__ Kh, const bf16* __restrict__ Vh, bf16* __restrict__ Ob, int kbase, int NT, char* lds, NbArgs nb) {
  int tid_ = threadIdx.x; asm volatile("" : "+v"(tid_));
  const int tid = tid_, wid = tid >> 6, lane = tid & 63, r32 = lane & 31, hi = lane >> 5;
  char* V_lds = lds; char* K_lds = lds + 2 * SHM_V;
  float* ws = (float*)(lds + 2 * SHM_V + 2 * SHM_K) + wid * 64; float* li_l = ws; float* al_l = ws + 32;
  const __attribute__((address_space(3))) float* rpbl = (const __attribute__((address_space(3))) float*)(uintptr_t)((unsigned)(uintptr_t)lds + RPB_OFF);
  __syncthreads();
  if (MODE == 1) { for (int i = tid; i < 15 * 31; i += 512) ((float*)(lds + RPB_OFF))[i] = nb.rpb_h[i] * (1.f / SCALE); }
  float m_reg = -1e30f, l_reg = 0; f32x16 o[4] = {}; bf16x8 qr[8];
  const bf16* Qw = Qb + (long)(wid * QBLK + r32) * LDQ + hi * 8;
#pragma unroll
  for (int d0 = 0; d0 < 8; ++d0) qr[d0] = *reinterpret_cast<const bf16x8*>(Qw + d0 * 16);
  const int sr = tid >> 4, sc = (tid & 15) * 8, vst0 = v_st(sr, sc), vst1 = v_st(32 + sr, sc);
  const int vb0 = (int)(unsigned)(uintptr_t)V_lds + v_rd_base(lane);
  struct { bf16x8 vs0, vs1, ks0, ks1; } sr_[SDEPTH];
#define KROW(t) (MODE == 0 ? kbase + (t) * KVBLK : ((t) < NB_WIN_TILES ? (nb.lo + (t)) * KVBLK : SEQ_LAT + ((t) - NB_WIN_TILES) * KVBLK))
#define SLOAD(i, t) do { const int k0_ = KROW(t); sr_[i].vs0 = *reinterpret_cast<const bf16x8*>(&Vh[(long)(k0_ + sr) * LDK + sc]); sr_[i].vs1 = *reinterpret_cast<const bf16x8*>(&Vh[(long)(k0_ + 32 + sr) * LDK + sc]); \
    sr_[i].ks0 = *reinterpret_cast<const bf16x8*>(&Kh[(long)(k0_ + sr) * LDK + sc]); sr_[i].ks1 = *reinterpret_cast<const bf16x8*>(&Kh[(long)(k0_ + 32 + sr) * LDK + sc]); } while (0)
#define SWRITE(b, i) do { *(bf16x8*)(V_lds + (b) * SHM_V + vst0) = sr_[i].vs0;          \
    *(bf16x8*)(V_lds + (b) * SHM_V + vst1) = sr_[i].vs1; int kc = sc * 2;               \
    *(bf16x8*)(K_lds + (b) * SHM_K + KSWZ(sr, kc)) = sr_[i].ks0;                       \
    *(bf16x8*)(K_lds + (b) * SHM_K + KSWZ(32 + sr, kc)) = sr_[i].ks1; } while (0)
#define SWAIT() do { if constexpr (SDEPTH == 2) asm volatile("s_waitcnt vmcnt(4)" ::: "memory"); else asm volatile("s_waitcnt vmcnt(0)" ::: "memory"); } while (0)
#define RESC(a) do { if (__any((a) < 1.f)) { if (hi == 0) al_l[r32] = (a); asm volatile("s_waitcnt lgkmcnt(0)" ::: "memory"); \
    _Pragma("unroll") for (int d = 0; d < 4; ++d) _Pragma("unroll") for (int r = 0; r < 16; ++r) o[d][r] *= al_l[crow(r, hi)]; } } while (0)
#define NBM(P0, P1, t) do { if (MODE == 1) nb_mask(P0, P1, (t), nb.lo, nb.qrow, nb.qcol, hi, rpbl); } while (0)
  f32x16 pA0, pA1; float mnA, alA; bf16x8 pa0, pa1, pa2, pa3;
  constexpr int SE = 0, SO = SDEPTH - 1;
  if constexpr (MODE == 1) {
    SLOAD(0, 0); asm volatile("s_waitcnt vmcnt(0)" ::: "memory"); SWRITE(0, 0); __syncthreads();
    for (int j = 0; j < NT; ++j) {
      const int b = j & 1;
      if (j + 1 < NT) SLOAD(0, j + 1);
      SBAR(); qkt(pA0, pA1, K_lds + b * SHM_K, qr, r32, hi); NBM(pA0, pA1, j);
      partialSM(pA0, pA1, m_reg, mnA, alA); RESC(alA);
      finishSM(pA0, pA1, alA, l_reg, pa0, pa1, pa2, pa3); SBAR();
      pv_d0(o, vb0 + b * (int)SHM_V, pa0, pa1, pa2, pa3);
      if (j + 1 < NT) { asm volatile("s_waitcnt vmcnt(0)" ::: "memory"); SWRITE(b ^ 1, 0); }
      __syncthreads();
    }
  } else {
  f32x16 pB0, pB1; float mnB, alB;
  SLOAD(SE, 0); asm volatile("s_waitcnt vmcnt(0)" ::: "memory"); SWRITE(0, SE); __syncthreads();
  qkt(pA0, pA1, K_lds, qr, r32, hi); partialSM(pA0, pA1, m_reg, mnA, alA);
  SLOAD(SO, 1); if constexpr (SDEPTH == 2) { if (2 < NT) SLOAD(SE, 2); }
  SWAIT(); SWRITE(1, SO); __syncthreads();
  for (int j = 1; j + 1 < NT; j += 2) {
    SBAR(); qkt(pB0, pB1, K_lds + SHM_K, qr, r32, hi);
    finishSM(pA0, pA1, alA, l_reg, pa0, pa1, pa2, pa3); SBAR();
    SLOAD(SO, j + SDEPTH); SBAR();
    pv_d0(o, vb0, pa0, pa1, pa2, pa3); partialSM(pB0, pB1, m_reg, mnB, alB);
    __syncthreads(); SWAIT(); SWRITE(0, SE);
    RESC(alB); __syncthreads();
    SBAR(); qkt(pA0, pA1, K_lds, qr, r32, hi);
    finishSM(pB0, pB1, alB, l_reg, pa0, pa1, pa2, pa3); SBAR();
    if (SDEPTH == 1 || j + 3 < NT) SLOAD(SE, j + 1 + SDEPTH); SBAR();
    pv_d0(o, vb0 + (int)SHM_V, pa0, pa1, pa2, pa3); partialSM(pA0, pA1, m_reg, mnA, alA);
    __syncthreads(); SWAIT(); SWRITE(1, SO);
    RESC(alA); __syncthreads();
  }
  SBAR(); qkt(pB0, pB1, K_lds + SHM_K, qr, r32, hi);
  finishSM(pA0, pA1, alA, l_reg, pa0, pa1, pa2, pa3); SBAR();
  pv_d0(o, vb0, pa0, pa1, pa2, pa3); partialSM(pB0, pB1, m_reg, mnB, alB);
  __syncthreads(); RESC(alB);
  finishSM(pB0, pB1, alB, l_reg, pa0, pa1, pa2, pa3); SBAR();
  pv_d0(o, vb0 + (int)SHM_V, pa0, pa1, pa2, pa3);
  }
  if (hi == 0) li_l[r32] = l_reg; asm volatile("s_waitcnt lgkmcnt(0)" ::: "memory");
  float rli[16];
#pragma unroll
  for (int r = 0; r < 16; ++r) rli[r] = __builtin_amdgcn_rcpf(li_l[crow(r, hi)]);
  bf16* Ow = Ob + (long)(wid * QBLK) * LDO;
#pragma unroll
  for (int r = 0; r < 16; ++r) { const int orow = crow(r, hi);
#pragma unroll
    for (int d0 = 0; d0 < 4; d0 += 1) { const unsigned pk = cvtpk(o[d0][r] * rli[r], 0.f); Ow[(long)orow * LDO + d0 * 32 + r32] = (bf16)(pk & 0xffffu); } }
#undef KROW
#undef SLOAD
#undef SWRITE
#undef SWAIT
#undef RESC
#undef NBM
}
#undef KSWZ
}
#define GAS __attribute__((address_space(1)))
#define LAS __attribute__((address_space(3)))
typedef unsigned short bf16;
typedef unsigned v4u __attribute__((ext_vector_type(4)));
typedef float f32x4 __attribute__((ext_vector_type(4)));
typedef short bf16x8 __attribute__((ext_vector_type(8)));
typedef GAS unsigned gu32;
typedef GAS unsigned long long gu64;
#define RLX_AGENT __ATOMIC_RELAXED, __HIP_MEMORY_SCOPE_AGENT
#define LDS_WAIT() asm volatile("s_waitcnt lgkmcnt(0)" ::: "memory")
#define VM_WAIT() asm volatile("s_waitcnt vmcnt(0)" ::: "memory")
__device__ __forceinline__ unsigned long long rt() { return __builtin_amdgcn_s_memrealtime(); }
__device__ __forceinline__ unsigned f2bf(float f) { unsigned u = __builtin_bit_cast(unsigned, f); return (u + 0x7fffu + ((u >> 16) & 1u)) >> 16; }
__device__ __forceinline__ unsigned pk2(float lo, float hi) { return f2bf(lo) | (f2bf(hi) << 16); }

#define XB_TMO      128
#define XB_XCNT(j)  (256  + 64 * (j))
#define XB_XSUB(j)  (1280 + 64 * (j))
#define XB_XGEN(j)  (2304 + 64 * (j))
#define XB_TOP      3328
#define XB_TOPGEN   3392
#define XCD_BAR_WORDS 3456
#define XB_SPIN_CAP (1u << 18)

__device__ __forceinline__ unsigned xb_ld(unsigned* p)              { return __hip_atomic_load(p, __ATOMIC_RELAXED, __HIP_MEMORY_SCOPE_AGENT); }
__device__ __forceinline__ unsigned xb_add(unsigned* p, unsigned v) { return __hip_atomic_fetch_add(p, v, __ATOMIC_RELAXED, __HIP_MEMORY_SCOPE_AGENT); }
__device__ __forceinline__ unsigned xb_xcc_id() { return (unsigned)__builtin_amdgcn_s_getreg((3 << 11) | 20) & 0xFu; }
#define XB_SPIN(cond, bar) do { unsigned _sp = 0; while (cond) { __builtin_amdgcn_s_sleep(1); \
    if ((++_sp & 255u) == 0u) { if (xb_ld(&(bar)[XB_TMO])) break; if (_sp > XB_SPIN_CAP) { atomicAdd(&(bar)[XB_TMO], 1u); break; } } } } while (0)

struct XcdBarrier {
    unsigned* bar; unsigned x;
    volatile LAS unsigned* st;
};

__device__ __forceinline__ XcdBarrier xcd_barrier_post(unsigned* bar, volatile LAS unsigned* st) {
    XcdBarrier b; b.bar = bar; b.x = xb_xcc_id(); b.st = st;
    if (threadIdx.x == 0) (void)xb_add(&bar[XB_XCNT(b.x)], 1u);
    return b;
}
__device__ __forceinline__ void xcd_barrier_complete(unsigned* bar, unsigned x, unsigned& nloc, unsigned& nx) {
    const unsigned G = gridDim.x * gridDim.y * gridDim.z;
    unsigned sum, cnt, mine, sp = 0u;
    for (;;) {
        sum = 0u; cnt = 0u; mine = 0u;
#pragma unroll
        for (unsigned j = 0; j < 16; ++j) { const unsigned c = xb_ld(&bar[XB_XCNT(j)]); sum += c; cnt += (c > 0u) ? 1u : 0u; mine = (j == x) ? c : mine; }
        if (sum == G) break;
        __builtin_amdgcn_s_sleep(1);
        if ((++sp & 255u) == 0u) { if (xb_ld(&bar[XB_TMO])) break; if (sp > XB_SPIN_CAP) { atomicAdd(&bar[XB_TMO], 1u); break; } }
    }
    nloc = mine > 0u ? mine : 1u; nx = cnt > 0u ? cnt : 1u;
}

__device__ __forceinline__ void xcd_barrier(const XcdBarrier& b) {
    asm volatile("s_waitcnt vmcnt(0)" ::: "memory");
    __syncthreads();
    if (threadIdx.x == 0) {
        unsigned* bar = b.bar;
        __builtin_amdgcn_s_waitcnt(0);
        unsigned nloc = b.st[0], nx = b.st[1];
        if (nloc == 0u) { xcd_barrier_complete(bar, b.x, nloc, nx); b.st[0] = nloc; b.st[1] = nx; }
        const unsigned old = xb_add(&bar[XB_XSUB(b.x)], 1u);
        const unsigned gen = old / nloc;
        if (old + 1u == (gen + 1u) * nloc) {
            __builtin_amdgcn_fence(__ATOMIC_RELEASE, "agent");
            asm volatile("s_waitcnt vmcnt(0)" ::: "memory");
            const unsigned og = xb_add(&bar[XB_TOP], 1u);
            const unsigned tg = og / nx;
            if (og + 1u == (tg + 1u) * nx) xb_add(&bar[XB_TOPGEN], 1u);
            else XB_SPIN(xb_ld(&bar[XB_TOPGEN]) == tg, bar);
            __builtin_amdgcn_fence(__ATOMIC_ACQUIRE, "agent");
            xb_add(&bar[XB_XGEN(b.x)], 1u);
            asm volatile("s_waitcnt vmcnt(0)" ::: "memory");
        } else {
            XB_SPIN(xb_ld(&bar[XB_XGEN(b.x)]) == gen, bar);
            __builtin_amdgcn_fence(__ATOMIC_ACQUIRE, "agent");
            asm volatile("s_waitcnt vmcnt(0)" ::: "memory");
        }
    }
    __syncthreads();
}

constexpr int NWAVES = 8;
constexpr int DM = 4096, SEQ = 16384, CTXL = 256, MTOT = SEQ + CTXL, DEPTH = 4, DFF = 6144, INC = 8192, RMOD = 256, NMOD = 9, MODW = NMOD * DM;
constexpr int CTX_PM = SEQ / 256;
constexpr float EPS = 1e-6f;
constexpr int C_QA = 0, C_KA = 2048, C_VA = 2560, C_QB = 3072, C_KB = 4096, C_VB = 5120, C_U = 6144, C_V = 7168;
constexpr int O_A = 0, O_B = 2048, O_C = 3072;
constexpr size_t MiB = 1u << 20;
constexpr size_t WS_CTL = 0, CTL_ZERO_BYTES = 1 * MiB;
constexpr size_t WS_MOD = 1 * MiB;
constexpr size_t WS_ROPE = 3 * MiB;
constexpr size_t WS_XR = 4 * MiB;
constexpr size_t WS_H = 264 * MiB;
constexpr size_t WS_ACT = 394 * MiB;
constexpr size_t WS_PROJ = 589 * MiB;
constexpr size_t WS_CAT = 849 * MiB;
constexpr size_t WS_W1 = 1024 * MiB;
constexpr size_t WS_W2 = 1792 * MiB;
constexpr size_t WS_WMI = 2176 * MiB;
constexpr size_t WS_WMO = 2432 * MiB;
constexpr size_t WS_END = 2560 * MiB;
static_assert(WS_XR + (size_t)MTOT * DM * 4 <= WS_H && WS_H + (size_t)MTOT * DM * 2 <= WS_ACT && WS_ACT + (size_t)MTOT * DFF * 2 <= WS_PROJ && WS_PROJ + (size_t)MTOT * INC * 2 <= WS_CAT &&
              WS_CAT + (size_t)MTOT * DM * 2 <= WS_W1 && WS_W1 + 8ull * 2 * DFF * DM * 2 <= WS_W2 && WS_W2 + 8ull * DM * DFF * 2 <= WS_WMI && WS_WMI + 4ull * INC * DM * 2 <= WS_WMO &&
              WS_WMO + 4ull * DM * DM * 2 <= WS_END && WS_MOD + (size_t)DEPTH * 2 * MODW * 4 <= WS_ROPE && WS_ROPE + 256 * 32 * 2 * 4 <= WS_XR, "d_ws map");
constexpr int CW_BAR = 4096;
constexpr int CW_T = 16384;
constexpr int RING_OFF = 0, RING_BYTES = 131072;
constexpr int LDSCTL_OFF = RING_BYTES, MISC_OFF = LDSCTL_OFF + 320;
constexpr int LDS_BYTES = 147456;
static_assert(MISC_OFF + 128 <= LDS_BYTES, "LDS map");

__device__ const float INV_FREQ[32] = {
  1.000000000e+00f, 7.498942614e-01f, 5.623413324e-01f, 4.216965139e-01f, 3.162277639e-01f, 2.371373773e-01f, 1.778279394e-01f, 1.333521307e-01f,
  1.000000015e-01f, 7.498941571e-02f, 5.623413250e-02f, 4.216965288e-02f, 3.162277490e-02f, 2.371373773e-02f, 1.778279431e-02f, 1.333521493e-02f,
  9.999999776e-03f, 7.498941850e-03f, 5.623413250e-03f, 4.216964822e-03f, 3.162277630e-03f, 2.371373586e-03f, 1.778279431e-03f, 1.333521446e-03f,
  1.000000047e-03f, 7.498942432e-04f, 5.623413017e-04f, 4.216965172e-04f, 3.162277571e-04f, 2.371373703e-04f, 1.778279402e-04f, 1.333521504e-04f };

struct Frame {
    LAS unsigned char* lds;
    volatile LAS unsigned* MISC;
    gu32* ctl;
    int vcu, G;
    const float* in[18];
    float* out;
    unsigned char* ws;
};
enum { I_X = 0, I_C, I_CTX, I_CCTX, I_NORMG, I_WDOWN, I_WUP, I_MODB, I_FWIN, I_FWOUT, I_MWIN, I_MWOUT, I_QKG, I_RPB, I_SGUG, I_SGUW, I_SGUB, I_FING };

__device__ __forceinline__ unsigned char* wsl(const Frame& F) { GAS unsigned char* p = (GAS unsigned char*)F.ws; asm volatile("" : "+s"(p)); return (unsigned char*)p; }
#define P_MOD(F)  ((float*)(wsl(F) + WS_MOD))
#define P_ROPE(F) ((float*)(wsl(F) + WS_ROPE))
#define P_XR(F)   ((float*)(wsl(F) + WS_XR))
#define P_H(F)    ((bf16*)(wsl(F) + WS_H))
#define P_ACT(F)  ((bf16*)(wsl(F) + WS_ACT))
#define P_PROJ(F) ((bf16*)(wsl(F) + WS_PROJ))
#define P_CAT(F)  ((bf16*)(wsl(F) + WS_CAT))
#define P_W1(F)   ((bf16*)(wsl(F) + WS_W1))
#define P_W2(F)   ((bf16*)(wsl(F) + WS_W2))
#define P_WMI(F)  ((bf16*)(wsl(F) + WS_WMI))
#define P_WMO(F)  ((bf16*)(wsl(F) + WS_WMO))
#define PH_IDS() int tid_ = threadIdx.x; asm volatile("" : "+v"(tid_)); const int tid = tid_, lane = tid & 63, wave = __builtin_amdgcn_readfirstlane(tid >> 6); (void)tid; (void)lane; (void)wave

__device__ __forceinline__ float wave_sum(float v) {
#pragma unroll
    for (int o = 1; o < 64; o <<= 1) v += __shfl_xor(v, o);
    return v;
}
__device__ __forceinline__ unsigned pkbf(float lo, float hi) { unsigned r; asm("v_cvt_pk_bf16_f32 %0, %1, %2" : "=v"(r) : "v"(lo), "v"(hi)); return r; }
__device__ __forceinline__ float bf_lo(unsigned w) { return __builtin_bit_cast(float, w << 16); }
__device__ __forceinline__ float bf_hi(unsigned w) { return __builtin_bit_cast(float, w & 0xffff0000u); }
__device__ __forceinline__ float gelu_tanh(float x) {
    const float z = 0.7978845608028654f * (x + 0.044715f * x * x * x);
    return x * __builtin_amdgcn_rcpf(1.f + __builtin_amdgcn_exp2f(z * -2.8853900817779268f));
}

__device__ __forceinline__ void transpose_item(const float* W, int K, int N, bf16* WT, int k0, int n0, int drow0, LAS float* scr, int lane) {
#pragma unroll 8
    for (int i = 0; i < 32; ++i) { const int kk = 2 * i + (lane >> 5); scr[kk * 33 + (lane & 31)] = W[(size_t)(k0 + kk) * N + n0 + (lane & 31)]; }
    LDS_WAIT(); asm volatile("" ::: "memory");
    const int c = lane & 7;
#pragma unroll
    for (int j = 0; j < 4; ++j) { const int n = (lane >> 3) + 8 * j; const LAS float* s = scr + (8 * c) * 33 + n;
        v4u o; o.x = pkbf(s[0 * 33], s[1 * 33]); o.y = pkbf(s[2 * 33], s[3 * 33]); o.z = pkbf(s[4 * 33], s[5 * 33]); o.w = pkbf(s[6 * 33], s[7 * 33]);
        *(GAS v4u*)(WT + (size_t)(drow0 + n) * K + k0 + 8 * c) = o; }
    LDS_WAIT(); asm volatile("" ::: "memory");
}

__device__ __forceinline__ void p0a(Frame& F) {
    PH_IDS();
    bf16* const W1 = P_W1(F); bf16* const W2 = P_W2(F); bf16* const WMI = P_WMI(F); bf16* const WMO = P_WMO(F); float* const XR = P_XR(F); float* const ROPE = P_ROPE(F);
    LAS float* scr = (LAS float*)(F.lds + RING_OFF + wave * 16384);
    const int gw = F.vcu * NWAVES + wave, NGW = F.G * NWAVES;
    constexpr int I_W1 = (DM / 64) * (2 * DFF / 32), I_W2 = (DFF / 64) * (DM / 32), I_MI = (DM / 64) * (INC / 32), I_MO = (DM / 64) * (DM / 32);
    constexpr int N_W1 = 8 * I_W1, N_W2 = 8 * I_W2, N_MI = 4 * I_MI, N_MO = 4 * I_MO, NITEMS = N_W1 + N_W2 + N_MI + N_MO;
    for (int it = gw; it < NITEMS; it += NGW) {
        int r = it;
        if (r < N_W1) { const int mat = r / I_W1; r -= mat * I_W1; const int nblk = 2 * DFF / 32, kb = r / nblk, nb = r % nblk, n0 = 32 * nb;
            const int drow0 = n0 < DFF ? ((n0 >> 7) * 256 + (n0 & 127)) : (((n0 - DFF) >> 7) * 256 + 128 + ((n0 - DFF) & 127));
            transpose_item(F.in[I_FWIN] + (size_t)mat * DM * 2 * DFF, DM, 2 * DFF, W1 + (size_t)mat * 2 * DFF * DM, 64 * kb, n0, drow0, scr, lane); continue; }
        r -= N_W1;
        if (r < N_W2) { const int mat = r / I_W2; r -= mat * I_W2; const int nblk = DM / 32, kb = r / nblk, nb = r % nblk;
            transpose_item(F.in[I_FWOUT] + (size_t)mat * DFF * DM, DFF, DM, W2 + (size_t)mat * DM * DFF, 64 * kb, 32 * nb, 32 * nb, scr, lane); continue; }
        r -= N_W2;
        if (r < N_MI) { const int mat = r / I_MI; r -= mat * I_MI; const int nblk = INC / 32, kb = r / nblk, nb = r % nblk;
            transpose_item(F.in[I_MWIN] + (size_t)mat * DM * INC, DM, INC, WMI + (size_t)mat * INC * DM, 64 * kb, 32 * nb, 32 * nb, scr, lane); continue; }
        r -= N_MI;
        { const int mat = r / I_MO; r -= mat * I_MO; const int nblk = DM / 32, kb = r / nblk, nb = r % nblk;
            transpose_item(F.in[I_MWOUT] + (size_t)mat * DM * DM, DM, DM, WMO + (size_t)mat * DM * DM, 64 * kb, 32 * nb, 32 * nb, scr, lane); }
    }
    for (int m = gw; m < MTOT; m += NGW) {
        const GAS f32x4* src = (const GAS f32x4*)(m < SEQ ? F.in[I_X] + (size_t)m * DM : F.in[I_CTX] + (size_t)(m - SEQ) * DM) + lane;
        GAS f32x4* dst = (GAS f32x4*)(XR + (size_t)m * DM) + lane;
#pragma unroll
        for (int j = 0; j < 16; ++j) dst[64 * j] = src[64 * j];
    }
    { const int gid = F.vcu * (NWAVES * 64) + tid;
      if (gid < 256 * 32) { const int pos = gid >> 5, i = gid & 31; const float angf = (float)pos * INV_FREQ[i]; const double a = (double)angf;
        const double nq = __builtin_rint(a * 0.63661977236758134308); const double rr = (a - nq * 1.5707963267948966192) - nq * 6.123233995736766e-17; const double r2 = rr * rr;
        const double sn = rr * (1.0 + r2 * (-1.0 / 6 + r2 * (1.0 / 120 + r2 * (-1.0 / 5040 + r2 * (1.0 / 362880 + r2 * (-1.0 / 39916800 + r2 * (1.0 / 6227020800.0)))))));
        const double cs = 1.0 + r2 * (-0.5 + r2 * (1.0 / 24 + r2 * (-1.0 / 720 + r2 * (1.0 / 40320 + r2 * (-1.0 / 3628800 + r2 * (1.0 / 479001600.0 + r2 * (-1.0 / 87178291200.0)))))));
        const int q = ((int)nq) & 3; const double c_ = (q == 0) ? cs : (q == 1) ? -sn : (q == 2) ? -cs : sn; const double s_ = (q == 0) ? sn : (q == 1) ? cs : (q == 2) ? -sn : -cs;
        ROPE[2 * gid] = (float)c_; ROPE[2 * gid + 1] = (float)s_; } }
    __syncthreads();
    for (int item = F.vcu; item < 256; item += F.G) {
        const int l = item >> 6, ch = item & 63; const float* Wd = F.in[I_WDOWN] + (size_t)l * DM * RMOD;
        f32x4 a0 = {0.f, 0.f, 0.f, 0.f}, a1 = a0;
#pragma unroll
        for (int i = 0; i < 8; ++i) { const int d = ch * 64 + wave * 8 + i; const float cv = F.in[I_C][d], cc = F.in[I_CCTX][d];
            const float s0 = cv / (1.f + __expf(-cv)), s1 = cc / (1.f + __expf(-cc)); const f32x4 w = *(const GAS f32x4*)(Wd + (size_t)d * RMOD + 4 * lane);
            a0 += w * s0; a1 += w * s1; }
        LAS float* red = (LAS float*)(F.lds + RING_OFF) + wave * 512;
        *(LAS f32x4*)(red + 4 * lane) = a0; *(LAS f32x4*)(red + 256 + 4 * lane) = a1;
        __syncthreads();
        { const LAS float* rb = (const LAS float*)(F.lds + RING_OFF) + tid; float s = 0.f;
#pragma unroll
          for (int w = 0; w < 8; ++w) s += rb[w * 512];
          atomicAdd((float*)(F.ctl + CW_T) + l * 512 + tid, s); }
        __syncthreads();
    }
}
__device__ __forceinline__ void p0b(Frame& F) {
    PH_IDS();
    float* const MOD = P_MOD(F);
    LAS float* tl = (LAS float*)(F.lds + RING_OFF); LAS f32x4* part = (LAS f32x4*)(F.lds + RING_OFF + 4096);
    for (int item = F.vcu; item < DEPTH * 36; item += F.G) {
        const int l = item / 36, jb = item % 36;
        tl[tid] = ((const GAS float*)(F.ctl + CW_T))[l * 512 + tid];
        __syncthreads();
        const int jl = tid & 255, rh = tid >> 8, j = (jb * 256 + jl) * 4;
        const float* Wu = F.in[I_WUP] + (size_t)l * RMOD * MODW + j;
        f32x4 a0 = {0.f, 0.f, 0.f, 0.f}, a1 = a0;
#pragma unroll 8
        for (int r = rh * 128; r < rh * 128 + 128; ++r) { const f32x4 w = *(const GAS f32x4*)(Wu + (size_t)r * MODW); a0 += w * tl[r]; a1 += w * tl[256 + r]; }
        if (rh == 1) { part[jl * 2] = a0; part[jl * 2 + 1] = a1; }
        __syncthreads();
        if (rh == 0) { const f32x4 b = *(const GAS f32x4*)(F.in[I_MODB] + (size_t)l * MODW + j); a0 += part[jl * 2] + b; a1 += part[jl * 2 + 1] + b;
            *(GAS f32x4*)(MOD + (size_t)(l * 2 + 0) * MODW + j) = a0; *(GAS f32x4*)(MOD + (size_t)(l * 2 + 1) * MODW + j) = a1; }
        __syncthreads();
    }
}
template <bool FINAL>
__device__ __forceinline__ void norm_phase(Frame& F, const float* g, const float* modl, const float* modc, int i_shift, int i_scale, bf16* H, float* out) {
    PH_IDS();
    const float* const XR = P_XR(F);
    LAS float* gs = (LAS float*)(F.lds + RING_OFF); LAS float* sh = gs + DM;
    for (int j = tid; j < DM; j += NWAVES * 64) {
        if (FINAL) gs[j] = g[j]; else { gs[j] = g[j] * (1.f + ((const GAS float*)modl)[i_scale * DM + j]); sh[j] = ((const GAS float*)modl)[i_shift * DM + j]; } }
    __syncthreads();
    const int gw = F.vcu * NWAVES + wave, NGW = F.G * NWAVES;
    for (int m = gw; m < (FINAL ? SEQ : MTOT); m += NGW) {
        const GAS f32x4* xr = (const GAS f32x4*)(XR + (size_t)m * DM) + lane;
        f32x4 v[16]; float ss = 0.f;
#pragma unroll
        for (int j = 0; j < 16; ++j) { v[j] = xr[64 * j]; ss += (v[j].x * v[j].x + v[j].y * v[j].y) + (v[j].z * v[j].z + v[j].w * v[j].w); }
        const float rstd = 1.f / sqrtf(wave_sum(ss) * (1.f / DM) + EPS);
        if (FINAL) { GAS f32x4* o = (GAS f32x4*)(out + (size_t)m * DM) + lane;
#pragma unroll
            for (int j = 0; j < 16; ++j) o[64 * j] = v[j] * rstd * *(const LAS f32x4*)(gs + 256 * j + 4 * lane);
        } else {
            GAS unsigned long long* o8 = (GAS unsigned long long*)(H + (size_t)m * DM) + lane;
            if (m < SEQ) {
#pragma unroll
                for (int j = 0; j < 16; ++j) { const f32x4 y = v[j] * rstd * *(const LAS f32x4*)(gs + 256 * j + 4 * lane) + *(const LAS f32x4*)(sh + 256 * j + 4 * lane);
                    o8[64 * j] = (unsigned long long)pkbf(y.x, y.y) | ((unsigned long long)pkbf(y.z, y.w) << 32); }
            } else {
#pragma unroll
                for (int j = 0; j < 16; ++j) { const int c = 256 * j + 4 * lane; const f32x4 gg = *(const GAS f32x4*)(g + c) * (*(const GAS f32x4*)(modc + i_scale * DM + c) + 1.f);
                    const f32x4 y = v[j] * rstd * gg + *(const GAS f32x4*)(modc + i_shift * DM + c);
                    o8[64 * j] = (unsigned long long)pkbf(y.x, y.y) | ((unsigned long long)pkbf(y.z, y.w) << 32); }
            }
        }
    }
}
__device__ __forceinline__ void qknorm_rows(Frame& F, const float* qkg  ) {
    PH_IDS();
    bf16* const PROJ = P_PROJ(F); const float* const ROPE = P_ROPE(F);
    const int gw = F.vcu * NWAVES + wave, NGW = F.G * NWAVES, hq = lane >> 4, q = lane & 15;
    for (int m = gw; m < MTOT; m += NGW) {
        bf16* prow = PROJ + (size_t)m * INC;
        const int pos = (q < 8) ? (m >> 6) : (m & 63);
        f32x4 cs[4];
        if (m < SEQ) { const GAS f32x4* tb = (const GAS f32x4*)(ROPE + (size_t)(pos * 32 + (q & 3) * 8) * 2);
#pragma unroll
            for (int e = 0; e < 4; ++e) cs[e] = tb[e]; }
#pragma unroll
        for (int st = 0; st < 5; ++st) {
            const int hh = st * 4 + hq; GAS v4u* p = (GAS v4u*)(prow + hh * 128 + 8 * q); const v4u raw = *p;
            float v[8] = {bf_lo(raw.x), bf_hi(raw.x), bf_lo(raw.y), bf_hi(raw.y), bf_lo(raw.z), bf_hi(raw.z), bf_lo(raw.w), bf_hi(raw.w)};
            float ss = 0.f;
#pragma unroll
            for (int e = 0; e < 8; ++e) ss += v[e] * v[e];
            ss += __shfl_xor(ss, 1); ss += __shfl_xor(ss, 2); ss += __shfl_xor(ss, 4); ss += __shfl_xor(ss, 8);
            const float rstd = 1.f / sqrtf(ss * (1.f / 128.f) + EPS);
            const float* gp = qkg + (st == 4 ? 128 : 0) + 8 * q; const f32x4 g0 = *(const f32x4*)gp, g1 = *(const f32x4*)(gp + 4);
            const float gg[8] = {g0.x, g0.y, g0.z, g0.w, g1.x, g1.y, g1.z, g1.w};
#pragma unroll
            for (int e = 0; e < 8; ++e) v[e] = v[e] * rstd * gg[e];
            if (m < SEQ) {
#pragma unroll
                for (int e = 0; e < 8; ++e) { const float yp = __shfl_xor(v[e], 4); const float c = (e & 1) ? cs[e >> 1].z : cs[e >> 1].x, s = (e & 1) ? cs[e >> 1].w : cs[e >> 1].y;
                    v[e] = (q & 4) ? (v[e] * c + yp * s) : (v[e] * c - yp * s); } }
            v4u o; o.x = pkbf(v[0], v[1]); o.y = pkbf(v[2], v[3]); o.z = pkbf(v[4], v[5]); o.w = pkbf(v[6], v[7]); *p = o;
        }
    }
}
constexpr int VNT_PITCH = 136;
__device__ __forceinline__ void sgu_unit(Frame& F, int n, int g, const float* gv  , const float* Wsl  , const float* bsl  ) {
    LAS bf16* VNT = (LAS bf16*)(F.lds + RING_OFF);
    PH_IDS();
    const bf16* const PROJ = P_PROJ(F); bf16* const CAT = P_CAT(F);
    const size_t row0 = (size_t)n * 128;
    __syncthreads();
#pragma unroll
    for (int i = 0; i < 4; ++i) { const int pid = tid + 512 * i, q = pid >> 4, c0 = (pid & 15) * 8;
        const v4u raw = *(const GAS v4u*)(PROJ + (row0 + q) * INC + C_V + g * 128 + c0);
        float v[8] = {bf_lo(raw.x), bf_hi(raw.x), bf_lo(raw.y), bf_hi(raw.y), bf_lo(raw.z), bf_hi(raw.z), bf_lo(raw.w), bf_hi(raw.w)};
        float ss = 0.f;
#pragma unroll
        for (int e = 0; e < 8; ++e) { v[e] = gelu_tanh(v[e]); ss += v[e] * v[e]; }
        ss += __shfl_xor(ss, 1); ss += __shfl_xor(ss, 2); ss += __shfl_xor(ss, 4); ss += __shfl_xor(ss, 8);
        const float rstd = 1.f / sqrtf(ss * (1.f / 128.f) + EPS);
        const float* gp = gv + g * 128 + c0; const f32x4 g0 = *(const f32x4*)gp, g1 = *(const f32x4*)(gp + 4);
        const float gg[8] = {g0.x, g0.y, g0.z, g0.w, g1.x, g1.y, g1.z, g1.w};
#pragma unroll
        for (int e = 0; e < 8; ++e) { const unsigned pk = pkbf(v[e] * rstd * gg[e], 0.f); VNT[(c0 + e) * VNT_PITCH + q] = (bf16)(pk & 0xffffu); } }
    __syncthreads();
    const int pb = wave & 3, ch = wave >> 2, r32 = lane & 31, hi = lane >> 5;
    att::f32x16 acc0 = {}, acc1 = {};
    const float* wrow = Wsl + ((size_t)g * 128 + pb * 32 + r32) * 128 + 8 * hi;
#pragma unroll
    for (int ks = 0; ks < 8; ++ks) {
        const f32x4 w0 = *(const f32x4*)(wrow + 16 * ks), w1 = *(const f32x4*)(wrow + 16 * ks + 4);
        v4u aw; aw.x = pkbf(w0.x, w0.y); aw.y = pkbf(w0.z, w0.w); aw.z = pkbf(w1.x, w1.y); aw.w = pkbf(w1.z, w1.w);
        const bf16x8 af = __builtin_bit_cast(bf16x8, aw);
        const bf16x8 b0 = *(const LAS bf16x8*)(VNT + (64 * ch + r32) * VNT_PITCH + 16 * ks + 8 * hi);
        const bf16x8 b1 = *(const LAS bf16x8*)(VNT + (64 * ch + 32 + r32) * VNT_PITCH + 16 * ks + 8 * hi);
        acc0 = __builtin_amdgcn_mfma_f32_32x32x16_bf16(af, b0, acc0, 0, 0, 0);
        acc1 = __builtin_amdgcn_mfma_f32_32x32x16_bf16(af, b1, acc1, 0, 0, 0); }
#pragma unroll
    for (int r = 0; r < 16; ++r) { const int p = pb * 32 + att::crow(r, hi); const float bs = bsl[g * 128 + p];
        const bf16* up = PROJ + (row0 + p) * INC + C_U + g * 128 + 64 * ch + r32; bf16* op = CAT + (row0 + p) * DM + O_C + g * 128 + 64 * ch + r32;
        const float u0 = bf_lo((unsigned)up[0]), u1 = bf_lo((unsigned)up[32]);
        op[0] = (bf16)(pkbf(gelu_tanh(u0) * (acc0[r] + bs), 0.f) & 0xffffu); op[32] = (bf16)(pkbf(gelu_tanh(u1) * (acc1[r] + bs), 0.f) & 0xffffu); }
}

#ifndef ATT1_SDEPTH
#define ATT1_SDEPTH 1
#endif
#ifndef ATT0_SDEPTH
#define ATT0_SDEPTH 2
#endif
struct Args { const float* in[18]; float* out; unsigned char* ws; };
__global__ void __launch_bounds__(NWAVES * 64, 2) dit_fwd(Args args) {
    extern __shared__ __attribute__((aligned(16))) unsigned char lds[];
    Frame F;
    F.lds = (LAS unsigned char*)lds;
    F.MISC = (volatile LAS unsigned*)(F.lds + MISC_OFF);
    F.G = gridDim.x; { const int bx = blockIdx.x; F.vcu = (F.G % 8 == 0) ? (bx % 8) * (F.G / 8) + bx / 8 : bx; }
    unsigned char* ws = args.ws;
    F.ctl = (gu32*)(ws + WS_CTL);
#pragma unroll
    for (int i = 0; i < 18; ++i) F.in[i] = args.in[i];
    F.out = args.out;
    F.ws = ws;
    for (int u = threadIdx.x; u < (LDS_BYTES - LDSCTL_OFF) / 4; u += NWAVES * 64) ((LAS unsigned*)(F.lds + LDSCTL_OFF))[u] = 0u;
    __syncthreads();
    XcdBarrier bar = xcd_barrier_post((unsigned*)(F.ctl + CW_BAR), F.MISC + 8);
#define GRID_BAR() do { XcdBarrier b_ = bar; asm volatile("" : "+s"(b_.x)); xcd_barrier(b_); } while (0)

    p0a(F); GRID_BAR();
    p0b(F); GRID_BAR();

    for (int f = 0; f < 2 * DEPTH; ++f) {
        const int l = f >> 1, hf = f & 1, kb = hf ? 6 : 0;

        { const float* modl = P_MOD(F) + (size_t)(l * 2) * MODW;
          norm_phase<false>(F, F.in[I_NORMG] + (size_t)(l * 3 + (hf ? 2 : 0)) * DM, modl, modl + MODW, kb + 0, kb + 1, P_H(F), nullptr); }
        GRID_BAR();
        { pg8::Gemm g{P_H(F), P_W1(F) + (size_t)f * 2 * DFF * DM, MTOT, 2 * DFF, DM}; pg8::StaticOrder S; S.init(MTOT, 2 * DFF, F.G, (int)blockIdx.x);
          pg8::EpiSwiGLU E{P_ACT(F), DFF};
          pg8::gemm_phase<pg8::EpiSwiGLU, pg8::StaticOrder, true, true>(F.lds + RING_OFF, g, S, E); }
        GRID_BAR();
        { const float* modl = P_MOD(F) + (size_t)(l * 2) * MODW; const float* modc = modl + MODW;
          pg8::Gemm g{P_ACT(F), P_W2(F) + (size_t)f * DM * DFF, MTOT, DM, DFF}; pg8::StaticOrder S; S.init(MTOT, DM, F.G, (int)blockIdx.x);
          pg8::EpiResid E{P_XR(F), DM, modl + (kb + 2) * DM, modc + (kb + 2) * DM, CTX_PM, 0.5f};
          pg8::gemm_phase<pg8::EpiResid, pg8::StaticOrder, true, true>(F.lds + RING_OFF, g, S, E); }
        GRID_BAR();
        if (hf == 0) {
            { const float* modl = P_MOD(F) + (size_t)(l * 2) * MODW;
              norm_phase<false>(F, F.in[I_NORMG] + (size_t)(l * 3 + 1) * DM, modl, modl + MODW, 3, 4, P_H(F), nullptr); }
            GRID_BAR();
            { pg8::Gemm g{P_H(F), P_WMI(F) + (size_t)l * INC * DM, MTOT, INC, DM}; pg8::StaticOrder S; S.init(MTOT, INC, F.G, (int)blockIdx.x);
              pg8::EpiBf16<0> E{P_PROJ(F), INC, nullptr, 0, 0, 1.f};
              pg8::gemm_phase<pg8::EpiBf16<0>, pg8::StaticOrder, true, true>(F.lds + RING_OFF, g, S, E); }
            GRID_BAR();
            for (int u = F.vcu; u < 512; u += F.G) {
                const bf16* const PROJ = P_PROJ(F); bf16* const CAT = P_CAT(F);
                const int h = u >> 6, blk = u & 63; int lo = 4 * blk - 4; lo = lo < 0 ? 0 : (lo > 244 ? 244 : lo);
                const int wv = __builtin_amdgcn_readfirstlane((int)(threadIdx.x >> 6));
                att::NbArgs nb{lo, 4 * blk + (wv >> 1), 32 * (wv & 1) + (int)(threadIdx.x & 31), F.in[I_RPB] + (size_t)(l * 8 + h) * 15 * 31};
#ifndef NO_ATT1
                att::attn_unit<1, INC, INC, DM, ATT1_SDEPTH>(PROJ + (size_t)(blk * 256) * INC + C_QB + h * 128, PROJ + C_KB + h * 128, PROJ + C_VB + h * 128,
                                                CAT + (size_t)(blk * 256) * DM + O_B + h * 128, 0, 16, (char*)lds + RING_OFF, nb);
#endif
            }
            for (int u = F.vcu; u < (MTOT / 128) * 8; u += F.G)
#ifndef NO_SGU
                sgu_unit(F, u >> 3, u & 7, F.in[I_SGUG] + (size_t)l * 1024, F.in[I_SGUW] + (size_t)l * 8 * 128 * 128, F.in[I_SGUB] + (size_t)l * 8 * 128);
#else
                ;
#endif
#ifndef NO_QKN
            qknorm_rows(F, F.in[I_QKG] + (size_t)l * 256);
#endif
            GRID_BAR();
            for (int u = F.vcu; u < 1024 + 16 + 8; u += F.G) {
                const bf16* const PROJ = P_PROJ(F); bf16* const CAT = P_CAT(F);
                att::NbArgs nb{0, 0, 0, nullptr};
                const bf16 *Qp, *Kp, *Vp; bf16* Op; int kbase, NT;
                if (u < 1024) { const int h = u >> 6, blk = u & 63, kvh = h >> 2;
                    Qp = PROJ + (size_t)(blk * 256) * INC + C_QA + h * 128; Kp = PROJ + C_KA + kvh * 128; Vp = PROJ + C_VA + kvh * 128;
                    Op = CAT + (size_t)(blk * 256) * DM + O_A + h * 128; kbase = 0; NT = MTOT / 64;
                } else if (u < 1040) { const int h = u - 1024, kvh = h >> 2;
                    Qp = PROJ + (size_t)SEQ * INC + C_QA + h * 128; Kp = PROJ + C_KA + kvh * 128; Vp = PROJ + C_VA + kvh * 128;
                    Op = CAT + (size_t)SEQ * DM + O_A + h * 128; kbase = SEQ; NT = CTXL / 64;
                } else { const int h = u - 1040;
                    Qp = PROJ + (size_t)SEQ * INC + C_QB + h * 128; Kp = PROJ + C_KB + h * 128; Vp = PROJ + C_VB + h * 128;
                    Op = CAT + (size_t)SEQ * DM + O_B + h * 128; kbase = SEQ; NT = CTXL / 64; }
#ifndef NO_ATT0
                att::attn_unit<0, INC, INC, DM, ATT0_SDEPTH>(Qp, Kp, Vp, Op, kbase, NT, (char*)lds + RING_OFF, nb);
#endif
            }
            GRID_BAR();
            { const float* modl = P_MOD(F) + (size_t)(l * 2) * MODW; const float* modc = modl + MODW;
              pg8::Gemm g{P_CAT(F), P_WMO(F) + (size_t)l * DM * DM, MTOT, DM, DM}; pg8::StaticOrder S; S.init(MTOT, DM, F.G, (int)blockIdx.x);
              pg8::EpiResid E{P_XR(F), DM, modl + 5 * DM, modc + 5 * DM, CTX_PM, 1.0f};
              pg8::gemm_phase<pg8::EpiResid, pg8::StaticOrder, true, true>(F.lds + RING_OFF, g, S, E); }
            GRID_BAR();
        }
    }
    norm_phase<true>(F, F.in[I_FING], nullptr, nullptr, 0, 0, nullptr, F.out);
    if (__hip_atomic_load((gu32*)((unsigned*)(F.ctl + CW_BAR) + XB_TMO), RLX_AGENT) != 0u) {
        const int gw = F.vcu * NWAVES + (int)(threadIdx.x >> 6), NGW = F.G * NWAVES; const float qn = __builtin_nanf("");
        for (int m = gw; m < SEQ; m += NGW) { GAS f32x4* o = (GAS f32x4*)(F.out + (size_t)m * DM) + (threadIdx.x & 63);
#pragma unroll
            for (int j = 0; j < 16; ++j) o[64 * j] = (f32x4){qn, qn, qn, qn}; }
    }
}

extern "C" void kernel_launch(void* const* d_in, const int* in_sizes, int n_in, void* d_out, int out_size, void* d_ws, size_t ws_size, hipStream_t stream) {
    static int grid = 0;
    if (grid == 0) {
        if (n_in != 18 || in_sizes[0] != SEQ * DM || out_size != SEQ * DM || ws_size < WS_END) {
            fprintf(stderr, "kernel_launch: built for 18 inputs, x/out of %d floats, >= %zu bytes of workspace; got n_in %d, in0 %d, out %d, ws %zu; nothing launched\n", SEQ * DM, (size_t)WS_END, n_in, n_in > 0 ? in_sizes[0] : -1, out_size, ws_size);
            grid = -1; return; }
        int dev = 0, cus = 0, per_cu = 0;
        if (hipGetDevice(&dev) != hipSuccess || hipDeviceGetAttribute(&cus, hipDeviceAttributeMultiprocessorCount, dev) != hipSuccess) { fprintf(stderr, "kernel_launch: device query failed\n"); grid = -1; return; }
        if (hipFuncSetAttribute((const void*)dit_fwd, hipFuncAttributeMaxDynamicSharedMemorySize, LDS_BYTES) != hipSuccess) { fprintf(stderr, "kernel_launch: hipFuncSetAttribute failed\n"); grid = -1; return; }
        if (hipOccupancyMaxActiveBlocksPerMultiprocessor(&per_cu, (const void*)dit_fwd, NWAVES * 64, LDS_BYTES) != hipSuccess || per_cu < 1)
            fprintf(stderr, "kernel_launch: note: occupancy query reports %d workgroups per CU\n", per_cu);
        (void)hipGetLastError();
        grid = cus;
    }
    if (grid < 0) return;
    if (hipMemsetAsync((char*)d_ws + WS_CTL, 0, CTL_ZERO_BYTES, stream) != hipSuccess) { fprintf(stderr, "kernel_launch: hipMemsetAsync failed\n"); return; }
    Args a{};
    for (int i = 0; i < 18; ++i) a.in[i] = (const float*)d_in[i];
    a.out = (float*)d_out; a.ws = (unsigned char*)d_ws;
    hipLaunchKernelGGL(dit_fwd, dim3(grid), dim3(NWAVES * 64), LDS_BYTES, stream, a);
    const hipError_t le = hipPeekAtLastError();
    if (le != hipSuccess) fprintf(stderr, "kernel_launch: launch failed: %s\n", hipGetErrorName(le));
}
```

```cpp
#include <hip/hip_runtime.h>
#include <cstdio>
#include <cstdint>
namespace pg8 {
#define PG8_LAS __attribute__((address_space(3)))
typedef unsigned short bf16_t;
typedef short bf16x8 __attribute__((ext_vector_type(8)));
typedef float f32x4 __attribute__((ext_vector_type(4)));
typedef unsigned u32x4 __attribute__((ext_vector_type(4)));
constexpr int BM = 256, BK = 64, HALF = 128, HTB = HALF * BK * 2  , STAGE_BYTES = 8 * HTB, NXCD = 8, WGM = 8;

__host__ __device__ __forceinline__ int lds_byte(int r, int c) { const int st = (r >> 4) * 2 + (c >> 5), rr = r & 15, cc = c & 31, ob = rr * 64 + cc * 2; return st * 1024 + (ob ^ (((ob >> 9) & 1) << 5)); }
__host__ __device__ __forceinline__ void stage_rc(int b, int& R, int& C) { const int st = b / 1024, sb = b % 1024, swz = sb ^ (((sb >> 9) & 1) << 5); R = (st >> 1) * 16 + swz / 64; C = (st & 1) * 32 + (swz % 64) / 2; }
__host__ __device__ __forceinline__ int perm32(int rho) { const int n = rho >> 4, i = rho & 15; return 8 * (i >> 2) + 4 * n + (i & 3); }

struct Unit { int pm, pn, kt0, nt; };
struct Gemm { const bf16_t* A; const bf16_t* Bt; int M, N, K; };

struct StaticOrder {
    int nM, nN, nwg, G, c, ntf;
    __host__ __device__ __forceinline__ void init(int M, int N, int K, int G_, int c_) { nM = M / BM; nN = N / BM; nwg = nM * nN; G = G_; c = c_; ntf = K / BK; }
    __host__ __device__ __forceinline__ bool next(int i, Unit& u) const {
        const long L = (long)i * G + c; if (L >= nwg) return false;
        int wgid = (int)L; { const int q = nwg / NXCD, r = nwg % NXCD, xcd = wgid % NXCD, off = wgid / NXCD; wgid = (xcd < r ? xcd * (q + 1) : r * (q + 1) + (xcd - r) * q) + off; }
        const int nig = WGM * nN, gid = wgid / nig, fm = gid * WGM, gsz = (nM - fm) < WGM ? (nM - fm) : WGM;
        u.pm = fm + ((wgid % nig) % gsz); u.pn = (wgid % nig) / gsz; u.kt0 = 0; u.nt = ntf; return true;
    }
    __device__ __forceinline__ void a_ready(const Unit&) const {}
    __device__ __forceinline__ void done(const Unit&) const {}
};
struct CtxSplitOrder : StaticOrder {
    int S, first, rev, ord;
    __host__ __device__ __forceinline__ void init(int Mlat, int N, int K, int S_, int G_, int c_, int first_) { StaticOrder::init(Mlat, N, K, G_, c_); S = S_; first = (S_ > 0) ? first_ : 0; rev = 0; ord = 0; }
    __host__ __device__ __forceinline__ bool next(int i, Unit& u) const {
        const int nmini = nN * S, rl = c < nwg ? (nwg - c + G - 1) / G : 0, rm = c < nmini ? (nmini - c + G - 1) / G : 0;
        const bool mini = first ? (i < rm) : (i >= rl); const int ii = first ? (mini ? i : i - rm) : (mini ? i - rl : i);
        const long L = (long)ii * G + c; const bool lat = !mini;
        int wgid = (lat && L < nwg) ? (int)L : 0; { const int q = nwg / NXCD, r = nwg % NXCD, xcd = wgid % NXCD, off = wgid / NXCD; wgid = (xcd < r ? xcd * (q + 1) : r * (q + 1) + (xcd - r) * q) + off; }
        const int nig = WGM * nN, gid = wgid / nig, fm = gid * WGM, gsz = (nM - fm) < WGM ? (nM - fm) : WGM;
#ifndef SQ_ROUND
#define SQ_ROUND 1
#endif
        const bool sq = SQ_ROUND && G == 256 && (nM & 15) == 0 && (nN & 15) == 0;
#ifndef SQ_ORDER
#define SQ_ORDER 0
#endif
        const int nsn = nN >> 4, nsm = nM >> 4, ri = lat ? i : 0, sm = (SQ_ORDER || ord) ? ri % (nsm > 0 ? nsm : 1) : ri / (nsn > 0 ? nsn : 1), sn = (SQ_ORDER || ord) ? ri / (nsm > 0 ? nsm : 1) : ri % (nsn > 0 ? nsn : 1), xq = c & 7, sl = c >> 3;
#ifndef SQ_SNAKE
#define SQ_SNAKE 0
#endif
        const int smr = rev ? (nsm - 1 - sm) : sm, snr = (SQ_SNAKE && !(SQ_ORDER || ord) && (sm & 1)) ? (nsn - 1 - sn) : sn;
        const int pm_q = SQ_ROUND == 2 ? 16 * smr + 4 * (xq >> 1) + (sl & 3) : 16 * smr + 8 * (xq >> 2) + (sl & 7), pn_q = SQ_ROUND == 2 ? 16 * snr + 8 * (xq & 1) + (sl >> 2) : 16 * snr + 4 * (xq & 3) + (sl >> 3);
        const int pm_l = sq ? pm_q : fm + ((wgid % nig) % gsz), pn_l = sq ? pn_q : (wgid % nig) / gsz;
        const int j = lat ? 0 : (int)L, Sd = S > 0 ? S : 1, ntm = ntf / Sd;
        u.pm = lat ? pm_l : nM; u.pn = lat ? pn_l : j / Sd; u.nt = lat ? ntf : ntm; u.kt0 = lat ? 0 : (j % Sd) * ntm;
        return lat ? (L < nwg) : (L < nmini);
    }
};

__device__ __forceinline__ unsigned cvt_pk_bf16(float lo, float hi) { unsigned r; asm volatile("v_cvt_pk_bf16_f32 %0, %1, %2" : "=v"(r) : "v"(lo), "v"(hi)); return r; }
typedef float f32x2 __attribute__((ext_vector_type(2)));
__device__ __forceinline__ f32x2 gelu_pk(f32x2 v) {
    const f32x2 av = __builtin_elementwise_abs(v), d = av * 0.2316418882f + 1.0f;
    f32x2 t; t.x = __builtin_amdgcn_rcpf(d.x); t.y = __builtin_amdgcn_rcpf(d.y);
    f32x2 q = t * 0.5307027145f + (-0.7265760135f); q = q * t + 0.7107068705f; q = q * t + (-0.142248368f); q = q * t + 0.127414796f; q = q * t;
    const f32x2 s = (v * v) * (-0.72134752044f);
    f32x2 e; e.x = __builtin_amdgcn_exp2f(s.x); e.y = __builtin_amdgcn_exp2f(s.y);
    const f32x2 m = v * (q * e), r = v - m;
    f32x2 o; o.x = v.x < 0.f ? m.x : r.x; o.y = v.y < 0.f ? m.y : r.y; return o;
}

template <int ACT  > struct EpiBf16 {
    static constexpr bool PERM = true, AFTER_DRAIN = false; static constexpr int OPND_AUX = 0; static_assert(ACT == 0 || ACT == 1, "EpiBf16: ACT is 0 (none) or 1 (gelu_pk)");
    bf16_t* O; int ldc; const float* bias; int split_cols; size_t split_stride; float scale0;
    __device__ __forceinline__ void operator()(const f32x4 (&acc)[2][2][4][2], const Unit& u, int wr, int wc, int fr, int fq) const {
        const int row0 = u.pm * BM + wr * 64 + fr; int colt = u.pn * BM; bf16_t* base = O;
        float sc = 1.f; if (split_cols) { const int t = colt / split_cols; base += (size_t)t * split_stride; colt -= t * split_cols; if (t == 0) sc = scale0; }
        const int col0 = colt + wc * 32 + 8 * fq, bcol0 = u.pn * BM + wc * 32 + 8 * fq;
        f32x4 bv[2][2];
#pragma unroll
        for (int bj = 0; bj < 2; ++bj)
#pragma unroll
            for (int n = 0; n < 2; ++n) bv[bj][n] = bias ? *(const f32x4*)(bias + bcol0 + bj * HALF + 4 * n) : (f32x4){0.f, 0.f, 0.f, 0.f};
#pragma unroll
        for (int ai = 0; ai < 2; ++ai)
#pragma unroll
            for (int m = 0; m < 4; ++m) { bf16_t* rowp = base + (size_t)(row0 + ai * HALF + m * 16) * ldc + col0;
#pragma unroll
                for (int bj = 0; bj < 2; ++bj) { f32x4 v0 = acc[ai][bj][m][0] + bv[bj][0], v1 = acc[ai][bj][m][1] + bv[bj][1];
                    if (ACT == 1) { f32x2 a = gelu_pk((f32x2){v0[0], v0[1]}), b = gelu_pk((f32x2){v0[2], v0[3]}), c = gelu_pk((f32x2){v1[0], v1[1]}), d = gelu_pk((f32x2){v1[2], v1[3]});
                        v0 = (f32x4){a.x, a.y, b.x, b.y}; v1 = (f32x4){c.x, c.y, d.x, d.y}; }
                    v0 = v0 * sc; v1 = v1 * sc; u32x4 w; w.x = cvt_pk_bf16(v0[0], v0[1]); w.y = cvt_pk_bf16(v0[2], v0[3]); w.z = cvt_pk_bf16(v1[0], v1[1]); w.w = cvt_pk_bf16(v1[2], v1[3]);
                    *(u32x4*)(rowp + bj * HALF) = w; } }
    }
};

struct EpiSwiGLU {
    static constexpr bool PERM = true, AFTER_DRAIN = false; static constexpr int OPND_AUX = 0;
    bf16_t* O; int ldc; int ctx_pm; bf16_t* slab;
    __device__ __forceinline__ void operator()(const f32x4 (&acc)[2][2][4][2], const Unit& u, int wr, int wc, int fr, int fq) const {
        const bool part = (u.pm >= ctx_pm);
        const int row0 = (part ? 0 : u.pm * BM) + wr * 64 + fr, col0 = u.pn * (part ? BM : HALF) + wc * 32 + 8 * fq, pitch = part ? 2 * ldc : ldc;
        bf16_t* base = part ? slab + (size_t)(u.kt0 / u.nt) * BM * (2 * ldc) : O;
#pragma unroll
        for (int ai = 0; ai < 2; ++ai)
#pragma unroll
            for (int m = 0; m < 4; ++m) {
                bf16_t* rowp = base + (size_t)(row0 + ai * HALF + m * 16) * pitch + col0;
                float r[8];
#pragma unroll
                for (int n = 0; n < 2; ++n)
#pragma unroll
                    for (int e = 0; e < 4; ++e) { const float a = acc[ai][0][m][n][e], b = acc[ai][1][m][n][e];
                        const float s = __builtin_amdgcn_rcpf(1.f + __builtin_amdgcn_exp2f(a * -1.4426950408889634f)); r[n * 4 + e] = part ? a : (a * s) * b; }
                u32x4 w; w.x = cvt_pk_bf16(r[0], r[1]); w.y = cvt_pk_bf16(r[2], r[3]); w.z = cvt_pk_bf16(r[4], r[5]); w.w = cvt_pk_bf16(r[6], r[7]);
#ifndef ACT_NT
#define ACT_NT 0
#endif
                if (ACT_NT) __builtin_nontemporal_store(w, (u32x4*)rowp); else *(u32x4*)rowp = w;
                if (part) { u32x4 wb; wb.x = cvt_pk_bf16(acc[ai][1][m][0][0], acc[ai][1][m][0][1]); wb.y = cvt_pk_bf16(acc[ai][1][m][0][2], acc[ai][1][m][0][3]);
                    wb.z = cvt_pk_bf16(acc[ai][1][m][1][0], acc[ai][1][m][1][1]); wb.w = cvt_pk_bf16(acc[ai][1][m][1][2], acc[ai][1][m][1][3]); *(u32x4*)(rowp + HALF) = wb; } }
    }
};
struct EpiStoreBf16 {
    static constexpr bool PERM = true, AFTER_DRAIN = false; static constexpr int OPND_AUX = 0;
    bf16_t* O; int ldc; int ctx_pm; bf16_t* slab;
    __device__ __forceinline__ void operator()(const f32x4 (&acc)[2][2][4][2], const Unit& u, int wr, int wc, int fr, int fq) const {
        const bool part = (u.pm >= ctx_pm);
        const int row0 = (part ? 0 : u.pm * BM) + wr * 64 + fr, col0 = u.pn * BM + wc * 32 + 8 * fq;
        bf16_t* base = part ? slab + (size_t)(u.kt0 / u.nt) * BM * ldc : O;
#pragma unroll
        for (int ai = 0; ai < 2; ++ai)
#pragma unroll
            for (int m = 0; m < 4; ++m) { bf16_t* rowp = base + (size_t)(row0 + ai * HALF + m * 16) * ldc + col0;
#pragma unroll
                for (int bj = 0; bj < 2; ++bj) { const f32x4 v0 = acc[ai][bj][m][0], v1 = acc[ai][bj][m][1];
                    u32x4 w; w.x = cvt_pk_bf16(v0[0], v0[1]); w.y = cvt_pk_bf16(v0[2], v0[3]); w.z = cvt_pk_bf16(v1[0], v1[1]); w.w = cvt_pk_bf16(v1[2], v1[3]);
                    *(u32x4*)(rowp + bj * HALF) = w; } }
    }
};
#ifndef RESID_OPND_AUX
#define RESID_OPND_AUX 0
#endif
struct EpiDelta {
    static constexpr bool PERM = true, AFTER_DRAIN = false; static constexpr int OPND_AUX = RESID_OPND_AUX;
    bf16_t* Dl; int ldc; const float* gate; const float* gate_c; int ctx_pm; float gs; bf16_t* slab;
    __device__ __forceinline__ void operator()(const f32x4 (&acc)[2][2][4][2], const Unit& u, int wr, int wc, int fr, int fq) const {
        const bool part = (u.pm >= ctx_pm);
        const int row0 = (part ? 0 : u.pm * BM) + wr * 64 + fr, col0 = u.pn * BM + wc * 32 + 8 * fq;
        const float* gp = part ? gate_c : gate;
        bf16_t* base = part ? slab + (size_t)(u.kt0 / u.nt) * BM * ldc : Dl;
        f32x4 gv[2][2];
#pragma unroll
        for (int bj = 0; bj < 2; ++bj)
#pragma unroll
            for (int n = 0; n < 2; ++n) gv[bj][n] = *(const f32x4*)(gp + col0 + bj * HALF + 4 * n) * gs;
#pragma unroll
        for (int ai = 0; ai < 2; ++ai)
#pragma unroll
            for (int m = 0; m < 4; ++m) { bf16_t* rowp = base + (size_t)(row0 + ai * HALF + m * 16) * ldc + col0;
#pragma unroll
                for (int bj = 0; bj < 2; ++bj) { const f32x4 v0 = gv[bj][0] * acc[ai][bj][m][0], v1 = gv[bj][1] * acc[ai][bj][m][1];
                    u32x4 w; w.x = cvt_pk_bf16(v0[0], v0[1]); w.y = cvt_pk_bf16(v0[2], v0[3]); w.z = cvt_pk_bf16(v1[0], v1[1]); w.w = cvt_pk_bf16(v1[2], v1[3]);
                    *(u32x4*)(rowp + bj * HALF) = w; } }
    }
};

template <class Epi, class Sched, bool ALIGN_EPI = false, bool SP2 = false>
__device__ __forceinline__ void gemm_phase(PG8_LAS unsigned char* lds, const Gemm g, const Sched& S, const Epi& E, int wid_in  ) {
    int tid_ = threadIdx.x; (void)wid_in; asm volatile("" : "+v"(tid_));
    const int tid = tid_, wid = __builtin_amdgcn_readfirstlane(tid >> 6), lane = tid & 63, wr = wid >> 2, wc = wid & 3, fr = lane & 15, fq = lane >> 4;
    const int K = g.K;
    unsigned voffA[2], voffB[2];
#pragma unroll
    for (int i = 0; i < 2; ++i) { int R, C; stage_rc(tid * 16 + i * 8192, R, C); const int Rb = Epi::PERM ? ((R & ~31) + perm32(R & 31)) : R;
        voffA[i] = (unsigned)(R * K + C) * 2u; voffB[i] = (unsigned)(Rb * K + C) * 2u; }
    const size_t kstep = (size_t)(BK * 2);
    const size_t hstep = (size_t)HALF * K * 2;
    const size_t tstep = 2 * hstep;
    const unsigned ldsw = (unsigned)wid * 1024u;
    const int aoff = lds_byte(wr * 64 + fr, fq * 8), boff = lds_byte(wc * 32 + fr, fq * 8);
#define PG8_SA(b, h) (((b) * 2 + (h)) * HTB)
#define PG8_SB(b, h) ((4 + (b) * 2 + (h)) * HTB)
#define PG8_STAGE(bufoff, gbase, voff) do { _Pragma("unroll") for (int _i = 0; _i < 2; ++_i) \
        __builtin_amdgcn_global_load_lds((const unsigned*)((const char*)(gbase) + (voff)[_i]), (PG8_LAS unsigned*)(lds + (bufoff) + ldsw + _i * 8192), 16, 0, Epi::OPND_AUX); } while (0)
#define PG8_LDA(dst, b, h) do { _Pragma("unroll") for (int m = 0; m < 4; ++m) _Pragma("unroll") for (int k = 0; k < 2; ++k) dst[m][k] = *(const PG8_LAS bf16x8*)(lds + PG8_SA(b, h) + aoff + m * 2048 + k * 1024); } while (0)
#define PG8_LDB(dst, b, h) do { _Pragma("unroll") for (int n = 0; n < 2; ++n) _Pragma("unroll") for (int k = 0; k < 2; ++k) dst[n][k] = *(const PG8_LAS bf16x8*)(lds + PG8_SB(b, h) + boff + n * 2048 + k * 1024); } while (0)
#define PG8_MMA(ai, bj, At, Bt) do { __builtin_amdgcn_s_setprio(1); _Pragma("unroll") for (int m = 0; m < 4; ++m) _Pragma("unroll") for (int n = 0; n < 2; ++n) _Pragma("unroll") for (int k = 0; k < 2; ++k) \
        acc[ai][bj][m][n] = __builtin_amdgcn_mfma_f32_16x16x32_bf16(Bt[n][k], At[m][k], acc[ai][bj][m][n], 0, 0, 0); __builtin_amdgcn_s_setprio(0); } while (0)
#define PG8_WAIT_V(n) asm volatile("s_waitcnt vmcnt(" #n ")" ::: "memory")
#define PG8_WAIT_L(n) asm volatile("s_waitcnt lgkmcnt(" #n ")" ::: "memory")
#define PG8_BAR __builtin_amdgcn_s_barrier()
#define PG8_SCHED __builtin_amdgcn_sched_barrier(0)
    Unit cur, nxt; int ui = 0;
    if (!S.next(0, cur)) return;
    f32x4 acc[2][2][4][2];
#pragma unroll
    for (int a = 0; a < 2; ++a)
#pragma unroll
        for (int b = 0; b < 2; ++b)
#pragma unroll
            for (int m = 0; m < 4; ++m)
#pragma unroll
                for (int n = 0; n < 2; ++n) acc[a][b][m][n] = (f32x4){0.f, 0.f, 0.f, 0.f};
    bf16x8 At[4][2], B0[2][2], B1[2][2];
    const char* cA = (const char*)g.A + (size_t)cur.pm * tstep + (size_t)cur.kt0 * kstep; const char* cB = (const char*)g.Bt + (size_t)cur.pn * tstep + (size_t)cur.kt0 * kstep;
    S.a_ready(cur);
    if constexpr (SP2) {
        PG8_STAGE(PG8_SB(0, 0), cB, voffB); PG8_STAGE(PG8_SB(0, 1), cB + hstep, voffB); PG8_STAGE(PG8_SA(0, 0), cA, voffA); PG8_STAGE(PG8_SA(0, 1), cA + hstep, voffA);
        if (wr == 1) PG8_BAR;
        PG8_WAIT_V(2); PG8_BAR;
        PG8_STAGE(PG8_SB(1, 0), cB + kstep, voffB); PG8_STAGE(PG8_SA(1, 0), cA + kstep, voffA); PG8_STAGE(PG8_SB(1, 1), cB + hstep + kstep, voffB);
        PG8_WAIT_V(6); PG8_BAR;
    } else {
        PG8_STAGE(PG8_SB(0, 0), cB, voffB); PG8_STAGE(PG8_SA(0, 0), cA, voffA); PG8_STAGE(PG8_SB(0, 1), cB + hstep, voffB); PG8_STAGE(PG8_SA(0, 1), cA + hstep, voffA);
        if (wr == 1) PG8_BAR;
        PG8_WAIT_V(4); PG8_BAR;
        PG8_STAGE(PG8_SB(1, 0), cB + kstep, voffB); PG8_STAGE(PG8_SA(1, 0), cA + kstep, voffA); PG8_STAGE(PG8_SB(1, 1), cB + hstep + kstep, voffB);
        PG8_WAIT_V(6); PG8_BAR;
    }
    for (;;) {
        const bool has_next = S.next(ui + 1, nxt);
        const char* nA = has_next ? (const char*)g.A + (size_t)nxt.pm * tstep + (size_t)nxt.kt0 * kstep : cA; const char* nB = has_next ? (const char*)g.Bt + (size_t)nxt.pn * tstep + (size_t)nxt.kt0 * kstep : cB;
        const int nt = cur.nt;
        for (int t = 0; t < nt; t += 2) {
            const bool last = (t == nt - 2);
            const char* a1 = cA + (size_t)(t + 1) * kstep;
            const char* a2 = last ? nA : cA + (size_t)(t + 2) * kstep; const char* b2 = last ? nB : cB + (size_t)(t + 2) * kstep;
            const char* a3 = a2 + kstep; const char* b3 = b2 + kstep;
            if (last && has_next) S.a_ready(nxt);
            if constexpr (SP2) {
            PG8_LDB(B0, 0, 0); PG8_LDB(B1, 0, 1); PG8_SCHED; PG8_LDA(At, 0, 0); PG8_STAGE(PG8_SA(1, 1), a1 + hstep, voffA);
            PG8_WAIT_V(8); PG8_WAIT_L(0); PG8_BAR; PG8_MMA(0, 0, At, B0); PG8_MMA(0, 1, At, B1); PG8_BAR; PG8_SCHED;
            PG8_LDA(At, 0, 1); PG8_STAGE(PG8_SB(0, 0), b2, voffB); PG8_STAGE(PG8_SB(0, 1), b2 + hstep, voffB); PG8_STAGE(PG8_SA(0, 0), a2, voffA);
            PG8_WAIT_V(8); PG8_WAIT_L(0); PG8_BAR; PG8_MMA(1, 0, At, B0); PG8_MMA(1, 1, At, B1); PG8_BAR; PG8_SCHED;
            PG8_LDB(B0, 1, 0); PG8_LDB(B1, 1, 1); PG8_SCHED; PG8_LDA(At, 1, 0); PG8_STAGE(PG8_SA(0, 1), a2 + hstep, voffA);
            PG8_WAIT_V(8); PG8_WAIT_L(0); PG8_BAR; PG8_MMA(0, 0, At, B0); PG8_MMA(0, 1, At, B1); PG8_BAR; PG8_SCHED;
            PG8_LDA(At, 1, 1); PG8_STAGE(PG8_SB(1, 0), b3, voffB); PG8_STAGE(PG8_SB(1, 1), b3 + hstep, voffB); PG8_STAGE(PG8_SA(1, 0), a3, voffA);
            PG8_WAIT_V(8); PG8_WAIT_L(0); PG8_BAR; PG8_MMA(1, 0, At, B0); PG8_MMA(1, 1, At, B1); PG8_BAR; PG8_SCHED;
            } else {
            PG8_LDB(B0, 0, 0); PG8_SCHED; PG8_LDA(At, 0, 0); PG8_STAGE(PG8_SA(1, 1), a1 + hstep, voffA);
            PG8_WAIT_L(8); PG8_BAR; PG8_WAIT_L(0); PG8_MMA(0, 0, At, B0); PG8_BAR; PG8_SCHED;
            PG8_LDB(B1, 0, 1); PG8_STAGE(PG8_SB(0, 0), b2, voffB);
            PG8_BAR; PG8_WAIT_L(0); PG8_MMA(0, 1, At, B1); PG8_BAR;
            PG8_LDA(At, 0, 1); PG8_STAGE(PG8_SA(0, 0), a2, voffA);
            PG8_BAR; PG8_WAIT_L(0); PG8_MMA(1, 0, At, B0); PG8_BAR; PG8_SCHED;
            PG8_STAGE(PG8_SB(0, 1), b2 + hstep, voffB);
            PG8_WAIT_V(6); PG8_BAR; PG8_MMA(1, 1, At, B1); PG8_BAR;
            PG8_LDB(B0, 1, 0); PG8_SCHED; PG8_LDA(At, 1, 0); PG8_STAGE(PG8_SA(0, 1), a2 + hstep, voffA);
            PG8_WAIT_L(8); PG8_BAR; PG8_WAIT_L(0); PG8_MMA(0, 0, At, B0); PG8_BAR; PG8_SCHED;
            PG8_LDB(B1, 1, 1); PG8_STAGE(PG8_SB(1, 0), b3, voffB);
            PG8_BAR; PG8_WAIT_L(0); PG8_MMA(0, 1, At, B1); PG8_BAR;
            PG8_LDA(At, 1, 1); PG8_STAGE(PG8_SA(1, 0), a3, voffA);
            PG8_BAR; PG8_WAIT_L(0); PG8_MMA(1, 0, At, B0); PG8_BAR; PG8_SCHED;
            PG8_STAGE(PG8_SB(1, 1), b3 + hstep, voffB);
            PG8_WAIT_V(6); PG8_BAR; PG8_MMA(1, 1, At, B1); PG8_BAR;
            }
        }
        if constexpr (ALIGN_EPI) { if (wr == 0) PG8_BAR; }
        if constexpr (!Epi::AFTER_DRAIN) { E(acc, cur, wr, wc, fr, fq); S.done(cur); }
        if (!has_next) break;
#pragma unroll
        for (int a = 0; a < 2; ++a)
#pragma unroll
            for (int b = 0; b < 2; ++b)
#pragma unroll
                for (int m = 0; m < 4; ++m)
#pragma unroll
                    for (int n = 0; n < 2; ++n) acc[a][b][m][n] = (f32x4){0.f, 0.f, 0.f, 0.f};
        cur = nxt; cA = nA; cB = nB; ++ui;
        if constexpr (ALIGN_EPI) { if (wr == 1) PG8_BAR; }
    }
    PG8_WAIT_V(0);
    if constexpr (!ALIGN_EPI) { if (wr == 0) PG8_BAR; }
    PG8_BAR;
    if constexpr (Epi::AFTER_DRAIN) { E.fused(acc, cur, wr, wc, fr, fq, lds, wid, lane); S.done(cur); }
#undef PG8_SA
#undef PG8_SB
#undef PG8_STAGE
#undef PG8_LDA
#undef PG8_LDB
#undef PG8_MMA
#undef PG8_WAIT_V
#undef PG8_WAIT_L
#undef PG8_BAR
#undef PG8_SCHED
}
}

namespace att {
typedef unsigned short bf16;
using bf16x8 = __attribute__((ext_vector_type(8))) short;
using s16x4  = __attribute__((ext_vector_type(4))) short;
using f32x16 = __attribute__((ext_vector_type(16))) float;
using u32x4  = __attribute__((ext_vector_type(4))) unsigned;
constexpr int   D = 128, NW = 8, QBLK = 32, KVBLK = 64;
constexpr float SCALE = 0.088388347648318440f;
constexpr float THR = 8.f;
#ifndef ATT0_RING3
#define ATT0_RING3 1
#endif
#ifndef ATT0_LEADBAR
#define ATT0_LEADBAR SBAR()
#endif
#ifndef ATT0_INBAR
#define ATT0_INBAR SBAR()
#endif
#ifndef ATT0_MIDBAR
#define ATT0_MIDBAR (void)0
#endif
#ifndef ATT0_PRIO
#define ATT0_PRIO 1
#endif
#define ATT0_NT 260
constexpr size_t SHM_V = KVBLK * D * 2, SHM_K = KVBLK * D * 2, SHM_ATTN = 2 * SHM_V + 2 * SHM_K + NW * 64 * 4;
constexpr int NRING = 4, WS_OFF = 131072 + 1024, RPB_OFF = WS_OFF + NW * 64 * 4;
constexpr int NB_WIN_TILES = 12, SEQ_LAT = 16384;
#define KSWZ(row, colB) ((row) * 256 + ((colB) ^ (((row) & 7) << 4)))
#define SBAR() __builtin_amdgcn_sched_barrier(0)
__device__ __forceinline__ int crow(int r, int hi) { return (r & 3) + 8 * (r >> 2) + 4 * hi; }
__device__ __forceinline__ unsigned cvtpk(float lo, float hi) {
  unsigned r; asm volatile("v_cvt_pk_bf16_f32 %0, %1, %2" : "=v"(r) : "v"(lo), "v"(hi)); return r;
}
__device__ __forceinline__ void partialSM(f32x16& p0, f32x16& p1, float& m_reg, float& mn, float& alpha) {
  constexpr float C = SCALE * 1.4426950408889634f;
  float pmax = p0[0];
#pragma unroll
  for (int r = 1; r < 16; ++r) pmax = fmaxf(pmax, p0[r]);
#pragma unroll
  for (int r = 0; r < 16; ++r) pmax = fmaxf(pmax, p1[r]);
  { auto rr = __builtin_amdgcn_permlane32_swap(__float_as_uint(pmax), __float_as_uint(pmax), false, false);
    pmax = fmaxf(__uint_as_float(rr[0]), __uint_as_float(rr[1])); }
  if (__builtin_expect(__all(pmax - m_reg <= THR / SCALE), 1)) { mn = m_reg; alpha = 1.f; }
  else { mn = fmaxf(m_reg, pmax); alpha = __builtin_amdgcn_exp2f((m_reg - mn) * C); m_reg = mn; }
  float mnC = -mn * C;
#pragma unroll
  for (int r = 0; r < 16; ++r) p0[r] = fmaf(p0[r], C, mnC);
#pragma unroll
  for (int r = 0; r < 16; ++r) p1[r] = fmaf(p1[r], C, mnC);
#pragma unroll
  for (int r = 0; r < 16; ++r) p0[r] = __builtin_amdgcn_exp2f(p0[r]);
}
__device__ __forceinline__ void finishSM(f32x16& p0, f32x16& p1, float alpha, float& l_reg, bf16x8& pa0, bf16x8& pa1, bf16x8& pa2, bf16x8& pa3) {
#pragma unroll
  for (int r = 0; r < 16; ++r) p1[r] = __builtin_amdgcn_exp2f(p1[r]);
  float ps = 0;
#pragma unroll
  for (int r = 0; r < 16; ++r) ps += p0[r];
#pragma unroll
  for (int r = 0; r < 16; ++r) ps += p1[r];
  { auto rr = __builtin_amdgcn_permlane32_swap(__float_as_uint(ps), __float_as_uint(ps), false, false);
    ps = __uint_as_float(rr[0]) + __uint_as_float(rr[1]); }
  l_reg = l_reg * alpha + ps;
#define PK4(P, BASE, OUT) do { unsigned a0 = cvtpk(P[BASE + 0], P[BASE + 1]), a1 = cvtpk(P[BASE + 2], P[BASE + 3]);   \
    unsigned b0 = cvtpk(P[BASE + 4], P[BASE + 5]), b1 = cvtpk(P[BASE + 6], P[BASE + 7]);                              \
    auto r0 = __builtin_amdgcn_permlane32_swap(a0, b0, false, false); auto r1 = __builtin_amdgcn_permlane32_swap(a1, b1, false, false); \
    u32x4 w = {r0[0], r1[0], r0[1], r1[1]}; OUT = *reinterpret_cast<bf16x8*>(&w); } while (0)
  PK4(p0, 0, pa0); PK4(p0, 8, pa1); PK4(p1, 0, pa2); PK4(p1, 8, pa3);
#undef PK4
}
__device__ __forceinline__ void qkt(f32x16& p0, f32x16& p1, const char* Ks, const bf16x8* qr, int r32, int hi) {
  p0 = f32x16{}; p1 = f32x16{};
#pragma unroll
  for (int d0 = 0; d0 < 8; ++d0) { int cb = (d0 * 16 + hi * 8) * 2;
    bf16x8 b0 = *reinterpret_cast<const bf16x8*>(Ks + KSWZ(r32, cb));
    bf16x8 b1 = *reinterpret_cast<const bf16x8*>(Ks + KSWZ(32 + r32, cb));
    p0 = __builtin_amdgcn_mfma_f32_32x32x16_bf16(b0, qr[d0], p0, 0, 0, 0);
    p1 = __builtin_amdgcn_mfma_f32_32x32x16_bf16(b1, qr[d0], p1, 0, 0, 0); }
}
__device__ __forceinline__ int v_st(int k, int c) { const int kk = (k & ~0xC) | ((k & 4) << 1) | ((k & 8) >> 1); return ((kk >> 3) * 4 + (c >> 5)) * 512 + ((kk & 7) * 32 + (c & 31)) * 2; }
__device__ __forceinline__ int v_rd_base(int lane) { return ((lane & 3) << 3) | (((lane >> 2) & 3) << 6) | (((lane >> 4) & 1) << 5) | (((lane >> 5) & 1) << 8); }
constexpr int v_rd_off(int d0, int ks, int half) { return d0 * 512 + ks * 4096 + half * 2048; }
template <int OFF> __device__ __forceinline__ s16x4 tr_read(int vb) {
  s16x4 r; asm volatile("ds_read_b64_tr_b16 %0, %1 offset:%2" : "=&v"(r) : "v"(vb), "i"(OFF) : "memory"); return r;
}
template <int D0> __device__ __forceinline__ void pv_one(f32x16& od, int vb, bf16x8 pa0, bf16x8 pa1, bf16x8 pa2, bf16x8 pa3) {
  const s16x4 l0 = tr_read<v_rd_off(D0, 0, 0)>(vb), h0 = tr_read<v_rd_off(D0, 0, 1)>(vb), l1 = tr_read<v_rd_off(D0, 1, 0)>(vb), h1 = tr_read<v_rd_off(D0, 1, 1)>(vb);
  const s16x4 l2 = tr_read<v_rd_off(D0, 2, 0)>(vb), h2 = tr_read<v_rd_off(D0, 2, 1)>(vb), l3 = tr_read<v_rd_off(D0, 3, 0)>(vb), h3 = tr_read<v_rd_off(D0, 3, 1)>(vb);
  asm volatile("s_waitcnt lgkmcnt(0)" ::: "memory"); SBAR();
#define PK(L, H) (bf16x8){L[0], L[1], L[2], L[3], H[0], H[1], H[2], H[3]}
  od = __builtin_amdgcn_mfma_f32_32x32x16_bf16(pa0, PK(l0, h0), od, 0, 0, 0);
  od = __builtin_amdgcn_mfma_f32_32x32x16_bf16(pa1, PK(l1, h1), od, 0, 0, 0);
  od = __builtin_amdgcn_mfma_f32_32x32x16_bf16(pa2, PK(l2, h2), od, 0, 0, 0);
  od = __builtin_amdgcn_mfma_f32_32x32x16_bf16(pa3, PK(l3, h3), od, 0, 0, 0);
#undef PK
}
__device__ __forceinline__ void pv_d0(f32x16* o, int vb, bf16x8 pa0, bf16x8 pa1, bf16x8 pa2, bf16x8 pa3) {
  pv_one<0>(o[0], vb, pa0, pa1, pa2, pa3); pv_one<1>(o[1], vb, pa0, pa1, pa2, pa3); pv_one<2>(o[2], vb, pa0, pa1, pa2, pa3); pv_one<3>(o[3], vb, pa0, pa1, pa2, pa3);
}
#define PK4F(P, BASE, OUT) do { unsigned a0 = cvtpk(P[BASE + 0], P[BASE + 1]), a1 = cvtpk(P[BASE + 2], P[BASE + 3]);   \
    unsigned b0 = cvtpk(P[BASE + 4], P[BASE + 5]), b1 = cvtpk(P[BASE + 6], P[BASE + 7]);                              \
    auto r0 = __builtin_amdgcn_permlane32_swap(a0, b0, false, false); auto r1 = __builtin_amdgcn_permlane32_swap(a1, b1, false, false); \
    u32x4 w = {r0[0], r1[0], r0[1], r1[1]}; OUT = *reinterpret_cast<bf16x8*>(&w); } while (0)
__device__ __forceinline__ void qkt_fsm(f32x16& c0, f32x16& c1, const char* Ks, const bf16x8* qr, int r32, int hi,
                                        f32x16& p0, f32x16& p1, float& l_reg, bf16x8& pa0, bf16x8& pa1, bf16x8& pa2, bf16x8& pa3) {
  c0 = f32x16{}; c1 = f32x16{};
  bf16x8 kf0[3], kf1[3]; float ps = 0.f;
#define KLD(d) do { const int cb_ = ((d) * 16 + hi * 8) * 2; kf0[(d) % 3] = *reinterpret_cast<const bf16x8*>(Ks + KSWZ(r32, cb_)); kf1[(d) % 3] = *reinterpret_cast<const bf16x8*>(Ks + KSWZ(32 + r32, cb_)); } while (0)
#define KMM(d) do { c0 = __builtin_amdgcn_mfma_f32_32x32x16_bf16(kf0[(d) % 3], qr[d], c0, 0, 0, 0); c1 = __builtin_amdgcn_mfma_f32_32x32x16_bf16(kf1[(d) % 3], qr[d], c1, 0, 0, 0); } while (0)
#define EXP4(P, B) do { P[B] = __builtin_amdgcn_exp2f(P[B]); P[B + 1] = __builtin_amdgcn_exp2f(P[B + 1]); P[B + 2] = __builtin_amdgcn_exp2f(P[B + 2]); P[B + 3] = __builtin_amdgcn_exp2f(P[B + 3]); } while (0)
#define SUM8(P, B) do { ps += ((P[B] + P[B + 1]) + (P[B + 2] + P[B + 3])) + ((P[B + 4] + P[B + 5]) + (P[B + 6] + P[B + 7])); } while (0)
  KLD(0); KLD(1);
  KLD(2); KMM(0); EXP4(p1, 0);  SUM8(p0, 0); ATT0_INBAR;
  KLD(3); KMM(1); EXP4(p1, 4);  SUM8(p0, 8); ATT0_INBAR;
  KLD(4); KMM(2); EXP4(p1, 8);  PK4F(p0, 0, pa0); ATT0_INBAR;
  KLD(5); KMM(3); EXP4(p1, 12); PK4F(p0, 8, pa1); ATT0_INBAR;
  KLD(6); KMM(4); SUM8(p1, 0); ATT0_INBAR;
  KLD(7); KMM(5); SUM8(p1, 8); ATT0_INBAR;
  KMM(6); PK4F(p1, 0, pa2); ATT0_INBAR;
  KMM(7); PK4F(p1, 8, pa3);
  { auto rr = __builtin_amdgcn_permlane32_swap(__float_as_uint(ps), __float_as_uint(ps), false, false); ps = __uint_as_float(rr[0]) + __uint_as_float(rr[1]); }
  l_reg += ps;
#undef KLD
#undef KMM
#undef SUM8
}
template <int D0> __device__ __forceinline__ void pv_one_exp(f32x16& od, int vb, bf16x8 pa0, bf16x8 pa1, bf16x8 pa2, bf16x8 pa3, f32x16& pc0) {
  pv_one<D0>(od, vb, pa0, pa1, pa2, pa3); EXP4(pc0, 4 * D0);
}
__device__ __forceinline__ void pv_exp(f32x16* o, int vb, bf16x8 pa0, bf16x8 pa1, bf16x8 pa2, bf16x8 pa3, f32x16& pc0) {
  pv_one_exp<0>(o[0], vb, pa0, pa1, pa2, pa3, pc0); pv_one_exp<1>(o[1], vb, pa0, pa1, pa2, pa3, pc0); pv_one_exp<2>(o[2], vb, pa0, pa1, pa2, pa3, pc0); pv_one_exp<3>(o[3], vb, pa0, pa1, pa2, pa3, pc0);
}
#undef EXP4
#undef PK4F
__device__ __forceinline__ void nb_mask(f32x16& p0, f32x16& p1, int j, int lo, int qr_, int qc, int hi, const __attribute__((address_space(3))) float* rpbl) {
  if (j >= NB_WIN_TILES) return;
  const int kr = lo + j; int r0 = qr_ - 4; r0 = r0 < 0 ? 0 : (r0 > 248 ? 248 : r0);
  const float NEG = -INFINITY;
  if (kr < r0 || kr >= r0 + 8) {
#pragma unroll
    for (int x = 0; x < 16; ++x) { p0[x] = NEG; p1[x] = NEG; }
    return; }
  int c0 = qc - 8; c0 = c0 < 0 ? 0 : (c0 > 48 ? 48 : c0);
  const __attribute__((address_space(3))) float* row = rpbl + (kr - qr_ + 7) * 31 + 15 - qc;
#pragma unroll
  for (int x = 0; x < 16; ++x) {
    const int kc0 = crow(x, hi), kc1 = kc0 + 32;
    const bool v0 = (unsigned)(kc0 - c0) < 16u, v1 = (unsigned)(kc1 - c0) < 16u;
    const float b0 = row[v0 ? kc0 : qc], b1 = row[v1 ? kc1 : qc];
    p0[x] = v0 ? p0[x] + b0 : NEG; p1[x] = v1 ? p1[x] + b1 : NEG;
    if ((x & 3) == 3) SBAR(); }
}
struct NbArgs { int lo, qrow, qcol; const float* rpb_h;
                const float* gq; const float* rope; int q0; };

template <int MODE, int LDQ, int LDK, int LDO, int SDEPTH  >
__device__ __forceinline__ void attn_unit(const bf16* __restrict__ Qb, const bf16* __restrict__ Kh, const bf16* __restrict__ Vh, bf16* __restrict__ Ob, int kbase_, int NT_, char* lds, NbArgs nb, int wid_in  ) {
  const int kbase = (MODE == 0) ? 0 : kbase_, NT = (MODE == 0) ? ATT0_NT : NT_;
  int tid_ = threadIdx.x; (void)wid_in; asm volatile("" : "+v"(tid_));
  const int tid = tid_, wid = tid >> 6, lane = tid & 63, r32 = lane & 31, hi = lane >> 5;
  char* K_lds = lds; char* V_lds = lds + NRING * SHM_K;
  float* ws = (float*)(lds + WS_OFF) + wid * 64; float* li_l = ws; float* al_l = ws + 32;
  const __attribute__((address_space(3))) float* rpbl = (const __attribute__((address_space(3))) float*)(uintptr_t)((unsigned)(uintptr_t)lds + RPB_OFF);
  __syncthreads();
  if (MODE == 1) { for (int i = tid; i < 15 * 31; i += 512) ((float*)(lds + RPB_OFF))[i] = nb.rpb_h[i] * (1.f / SCALE); }
  float m_reg = -1e30f, l_reg = 0; f32x16 o[4] = {}; bf16x8 qr[8];
  const bf16* Qw = Qb + (long)(wid * QBLK + r32) * LDQ + hi * 8;
#pragma unroll
  for (int d0 = 0; d0 < 8; ++d0) qr[d0] = *reinterpret_cast<const bf16x8*>(Qw + d0 * 16);
  if (MODE == 0 && nb.gq != nullptr) {
    float qf[8][8]; float ss = 0.f;
#pragma unroll
    for (int d0 = 0; d0 < 8; ++d0) { const u32x4 w = *reinterpret_cast<const u32x4*>(&qr[d0]);
#pragma unroll
      for (int k = 0; k < 4; ++k) { const unsigned x = w[k]; qf[d0][2 * k] = __uint_as_float(x << 16); qf[d0][2 * k + 1] = __uint_as_float(x & 0xffff0000u); } }
#pragma unroll
    for (int d0 = 0; d0 < 8; ++d0)
#pragma unroll
      for (int j = 0; j < 8; ++j) ss += qf[d0][j] * qf[d0][j];
    { auto rr = __builtin_amdgcn_permlane32_swap(__float_as_uint(ss), __float_as_uint(ss), false, false); ss = __uint_as_float(rr[0]) + __uint_as_float(rr[1]); }
    const float rs = (1.f / sqrtf(ss * (1.f / 128.f) + 1e-6f)) * (SCALE * 1.4426950408889634f);
#pragma unroll
    for (int d0 = 0; d0 < 8; ++d0) { const float* gp = nb.gq + 16 * d0 + 8 * hi;
#pragma unroll
      for (int j = 0; j < 8; ++j) qf[d0][j] *= rs * gp[j]; SBAR(); }
    const int tok = nb.q0 + wid * QBLK + r32;
#pragma unroll
    for (int ax = 0; ax < 2; ++ax) { const int pos = ax ? (tok & 63) : (tok >> 6);
#pragma unroll
      for (int k = 0; k < 2; ++k) { const float* tb = nb.rope + (size_t)(pos * 32 + 16 * k + 8 * hi) * 2; const int da = 4 * ax + k, db = da + 2;
#pragma unroll
        for (int j = 0; j < 8; ++j) { const float c = tb[2 * j], s = tb[2 * j + 1], xa = qf[da][j], xb = qf[db][j];
          qf[da][j] = xa * c - xb * s; qf[db][j] = xb * c + xa * s; } SBAR(); } }
#pragma unroll
    for (int d0 = 0; d0 < 8; ++d0) { u32x4 w = {cvtpk(qf[d0][0], qf[d0][1]), cvtpk(qf[d0][2], qf[d0][3]), cvtpk(qf[d0][4], qf[d0][5]), cvtpk(qf[d0][6], qf[d0][7])}; qr[d0] = *reinterpret_cast<bf16x8*>(&w); }
  }
  const int vb0 = (int)(unsigned)(uintptr_t)V_lds + v_rd_base(lane);
#define KROW(t) (MODE != 1 ? kbase + (t) * KVBLK : ((t) < NB_WIN_TILES ? (nb.lo + (t)) * KVBLK : SEQ_LAT + ((t) - NB_WIN_TILES) * KVBLK))
#define RESC(a) do { if (__any((a) < 1.f)) { if (hi == 0) al_l[r32] = (a); asm volatile("s_waitcnt lgkmcnt(0)" ::: "memory"); \
    _Pragma("unroll") for (int d = 0; d < 4; ++d) _Pragma("unroll") for (int r = 0; r < 16; ++r) o[d][r] *= al_l[crow(r, hi)]; } } while (0)
#define NBM(P0, P1, t) do { if (MODE == 1) nb_mask(P0, P1, (t), nb.lo, nb.qrow, nb.qcol, hi, rpbl); } while (0)
#define VWAIT0() asm volatile("s_waitcnt vmcnt(0)" ::: "memory")
#define EXPA(P0) do { _Pragma("unroll") for (int r_ = 0; r_ < 16; ++r_) P0[r_] = __builtin_amdgcn_exp2f(P0[r_]); } while (0)
  typedef const __attribute__((address_space(1))) unsigned* gsrc_t; typedef __attribute__((address_space(3))) unsigned* ldst_t;
  const int wv_ = __builtin_amdgcn_readfirstlane(wid);
  unsigned koffA, koffB, voffA, voffB;
  { const int rowA = 8 * wv_ + (lane >> 4), rowB = rowA + 4, s_ = lane & 15;
    koffA = (unsigned)((rowA * LDK + ((s_ ^ (rowA & 7)) << 3)) * 2); koffB = (unsigned)((rowB * LDK + ((s_ ^ (rowB & 7)) << 3)) * 2);
    const int stA = 4 * wv_ + (lane >> 5), stB = stA + 2, kkA = (stA >> 2) * 8 + ((lane & 31) >> 2), kkB = (stB >> 2) * 8 + ((lane & 31) >> 2);
    const int kA = (kkA & ~0xC) | ((kkA & 4) << 1) | ((kkA & 8) >> 1), kB = (kkB & ~0xC) | ((kkB & 4) << 1) | ((kkB & 8) >> 1);
    voffA = (unsigned)((kA * LDK + (stA & 3) * 32 + (lane & 3) * 8) * 2); voffB = (unsigned)((kB * LDK + (stB & 3) * 32 + (lane & 3) * 8) * 2); }
  const unsigned kl_ = (unsigned)(uintptr_t)K_lds + (unsigned)wv_ * 2048u, vl_ = (unsigned)(uintptr_t)V_lds + (unsigned)wv_ * 2048u;
#define DMA_TILE(t, BO) do { const char* kt_ = (const char*)Kh + (size_t)KROW(t) * (size_t)(LDK * 2); const char* vt_ = (const char*)Vh + (size_t)KROW(t) * (size_t)(LDK * 2); \
    __builtin_amdgcn_global_load_lds((gsrc_t)(kt_ + koffA), (ldst_t)(uintptr_t)(kl_ + (unsigned)(BO)), 16, 0, 0); \
    __builtin_amdgcn_global_load_lds((gsrc_t)(kt_ + koffB), (ldst_t)(uintptr_t)(kl_ + (unsigned)(BO) + 1024u), 16, 0, 0); \
    __builtin_amdgcn_global_load_lds((gsrc_t)(vt_ + voffA), (ldst_t)(uintptr_t)(vl_ + (unsigned)(BO)), 16, 0, 0); \
    __builtin_amdgcn_global_load_lds((gsrc_t)(vt_ + voffB), (ldst_t)(uintptr_t)(vl_ + (unsigned)(BO) + 1024u), 16, 0, 0); } while (0)
  f32x16 pA0, pA1; float mnA, alA; bf16x8 pa0, pa1, pa2, pa3;
  if constexpr (MODE != 0) {
#define BAR_KEEP(ntl) do { if ((ntl) >= 2) asm volatile("s_waitcnt vmcnt(8) lgkmcnt(0)" ::: "memory"); else if ((ntl) == 1) asm volatile("s_waitcnt vmcnt(4) lgkmcnt(0)" ::: "memory"); \
    else asm volatile("s_waitcnt vmcnt(0) lgkmcnt(0)" ::: "memory"); __builtin_amdgcn_s_barrier(); asm volatile("" ::: "memory"); } while (0)
    DMA_TILE(0, 0); if (NT > 1) DMA_TILE(1, (int)SHM_K); if (NT > 2) DMA_TILE(2, 2 * (int)SHM_K);
    BAR_KEEP(NT > 2 ? 2 : (NT > 1 ? 1 : 0));
    for (int j = 0; j < NT; ++j) {
      const int b = (j & 3) * (int)SHM_K;
      if (j + 3 < NT) DMA_TILE(j + 3, ((j + 3) & 3) * (int)SHM_K);
      bool live = true;
      if (MODE == 1 && j < NB_WIN_TILES) { int r0_ = nb.qrow - 4; r0_ = r0_ < 0 ? 0 : (r0_ > 248 ? 248 : r0_); live = (nb.lo + j >= r0_) && (nb.lo + j < r0_ + 8); }
      if (live) {
      SBAR(); qkt(pA0, pA1, K_lds + b, qr, r32, hi); NBM(pA0, pA1, j);
      partialSM(pA0, pA1, m_reg, mnA, alA); RESC(alA);
      finishSM(pA0, pA1, alA, l_reg, pa0, pa1, pa2, pa3); SBAR();
      pv_d0(o, vb0 + b, pa0, pa1, pa2, pa3);
      }
      BAR_KEEP(j + 3 < NT ? 2 : (j + 2 < NT ? 1 : 0));
    }
#undef BAR_KEEP
  } else {
  f32x16 pB0, pB1;
#if ATT0_PRIO
  if (wv_ >= 4) __builtin_amdgcn_s_setprio(1);
#endif
#define BARK(more) do { if (more) asm volatile("s_waitcnt vmcnt(4) lgkmcnt(0)" ::: "memory"); else asm volatile("s_waitcnt vmcnt(0) lgkmcnt(0)" ::: "memory"); \
    __builtin_amdgcn_s_barrier(); asm volatile("" ::: "memory"); } while (0)
#define HSTEP(t, BC, BP, BN2, PC0, PC1, PP0, PP1) do { \
    const bool more_ = ((t) + 2 < NT); if (more_) DMA_TILE((t) + 2, BN2); \
    ATT0_LEADBAR; qkt_fsm(PC0, PC1, K_lds + (BC), qr, r32, hi, PP0, PP1, l_reg, pa0, pa1, pa2, pa3); ATT0_MIDBAR; \
    pv_exp(o, vb0 + (BP), pa0, pa1, pa2, pa3, PC0); \
    BARK(more_); } while (0)
  constexpr int B0 = 0, B1 = (int)SHM_K, B2 = 2 * (int)SHM_K, B3 = 3 * (int)SHM_K;
  static_assert((ATT0_NT - 4) % 4 == 0 && ATT0_NT >= 8, "MODE 0 tile count: two lead-in half-steps, then groups of four");
  DMA_TILE(0, B0); DMA_TILE(1, B1); BARK(true);
  DMA_TILE(2, B2);
  qkt(pA0, pA1, K_lds + B0, qr, r32, hi); EXPA(pA0);
  BARK(true);
  HSTEP(1, B1, B0, B3, pB0, pB1, pA0, pA1);
  HSTEP(2, B2, B1, B0, pA0, pA1, pB0, pB1);
  for (int j = 3; j + 3 < NT; j += 4) {
    HSTEP(j,     B3, B2, B1, pB0, pB1, pA0, pA1);
    HSTEP(j + 1, B0, B3, B2, pA0, pA1, pB0, pB1);
    HSTEP(j + 2, B1, B0, B3, pB0, pB1, pA0, pA1);
    HSTEP(j + 3, B2, B1, B0, pA0, pA1, pB0, pB1);
  }
  SBAR(); qkt(pB0, pB1, K_lds + B3, qr, r32, hi);
  finishSM(pA0, pA1, 1.f, l_reg, pa0, pa1, pa2, pa3); SBAR();
  pv_d0(o, vb0 + B2, pa0, pa1, pa2, pa3); EXPA(pB0);
  finishSM(pB0, pB1, 1.f, l_reg, pa0, pa1, pa2, pa3); SBAR();
  pv_d0(o, vb0 + B3, pa0, pa1, pa2, pa3);
#undef BARK
#if ATT0_PRIO
  __builtin_amdgcn_s_setprio(0);
#endif
  }
#undef DMA_TILE
#undef EXPA
#undef HSTEP
#undef VWAIT0
  if (hi == 0) li_l[r32] = l_reg; asm volatile("s_waitcnt lgkmcnt(0)" ::: "memory");
  float rli[16];
#pragma unroll
  for (int r = 0; r < 16; ++r) rli[r] = __builtin_amdgcn_rcpf(li_l[crow(r, hi)]);
  bf16* Ow = Ob + (long)(wid * QBLK) * LDO;
#pragma unroll
  for (int r = 0; r < 16; ++r) { const int orow = crow(r, hi);
#pragma unroll
    for (int d0 = 0; d0 < 4; d0 += 1) { const unsigned pk = cvtpk(o[d0][r] * rli[r], 0.f); Ow[(long)orow * LDO + d0 * 32 + r32] = (bf16)(pk & 0xffffu); } }
#undef KROW
#undef RESC
#undef NBM
}
#undef KSWZ
}
#define GAS __attribute__((address_space(1)))
#define LAS __attribute__((address_space(3)))
typedef unsigned short bf16;
typedef unsigned v4u __attribute__((ext_vector_type(4)));
typedef float f32x4 __attribute__((ext_vector_type(4)));
typedef short bf16x8 __attribute__((ext_vector_type(8)));
typedef GAS unsigned gu32;
typedef GAS unsigned long long gu64;
#define RLX_AGENT __ATOMIC_RELAXED, __HIP_MEMORY_SCOPE_AGENT
#define LDS_WAIT() asm volatile("s_waitcnt lgkmcnt(0)" ::: "memory")
#define VM_WAIT() asm volatile("s_waitcnt vmcnt(0)" ::: "memory")
__device__ __forceinline__ unsigned long long rt() { return __builtin_amdgcn_s_memrealtime(); }
__device__ __forceinline__ unsigned f2bf(float f) { unsigned u = __builtin_bit_cast(unsigned, f); return (u + 0x7fffu + ((u >> 16) & 1u)) >> 16; }
__device__ __forceinline__ unsigned pk2(float lo, float hi) { return f2bf(lo) | (f2bf(hi) << 16); }

#define XB_TMO      128
#define XB_XCNT(j)  (256  + 64 * (j))
#define XB_XSUB(j)  (1280 + 64 * (j))
#define XB_XGEN(j)  (2304 + 64 * (j))
#define XB_TOP      3328
#define XB_TOPGEN   3392
#define XCD_BAR_WORDS 3456
#define XB_SPIN_CAP (1u << 18)

__device__ __forceinline__ unsigned xb_ld(unsigned* p)              { return __hip_atomic_load(p, __ATOMIC_RELAXED, __HIP_MEMORY_SCOPE_AGENT); }
__device__ __forceinline__ unsigned xb_add(unsigned* p, unsigned v) { return __hip_atomic_fetch_add(p, v, __ATOMIC_RELAXED, __HIP_MEMORY_SCOPE_AGENT); }
__device__ __forceinline__ unsigned xb_xcc_id() { return (unsigned)__builtin_amdgcn_s_getreg((3 << 11) | 20) & 0xFu; }
#define XB_SPIN(cond, bar) do { unsigned _sp = 0; while (cond) { __builtin_amdgcn_s_sleep(1); \
    if ((++_sp & 255u) == 0u) { if (xb_ld(&(bar)[XB_TMO])) break; if (_sp > XB_SPIN_CAP) { atomicAdd(&(bar)[XB_TMO], 1u); break; } } } } while (0)

struct XcdBarrier {
    unsigned* bar; unsigned x;
    volatile LAS unsigned* st;
};

__device__ __forceinline__ XcdBarrier xcd_barrier_post(unsigned* bar, volatile LAS unsigned* st) {
    XcdBarrier b; b.bar = bar; b.x = xb_xcc_id(); b.st = st;
    if (threadIdx.x == 0) (void)xb_add(&bar[XB_XCNT(b.x)], 1u);
    return b;
}
__device__ __forceinline__ void xcd_barrier_complete(unsigned* bar, unsigned x, unsigned& nloc, unsigned& nx) {
    const unsigned G = gridDim.x * gridDim.y * gridDim.z;
    unsigned sum, cnt, mine, sp = 0u;
    for (;;) {
        sum = 0u; cnt = 0u; mine = 0u;
#pragma unroll
        for (unsigned j = 0; j < 16; ++j) { const unsigned c = xb_ld(&bar[XB_XCNT(j)]); sum += c; cnt += (c > 0u) ? 1u : 0u; mine = (j == x) ? c : mine; }
        if (sum == G) break;
        __builtin_amdgcn_s_sleep(1);
        if ((++sp & 255u) == 0u) { if (xb_ld(&bar[XB_TMO])) break; if (sp > XB_SPIN_CAP) { atomicAdd(&bar[XB_TMO], 1u); break; } }
    }
    nloc = mine > 0u ? mine : 1u; nx = cnt > 0u ? cnt : 1u;
}

__device__ __forceinline__ void xcd_barrier(const XcdBarrier& b) {
    asm volatile("s_waitcnt vmcnt(0)" ::: "memory");
    __syncthreads();
    if (threadIdx.x == 0) {
        unsigned* bar = b.bar;
        __builtin_amdgcn_s_waitcnt(0);
        unsigned nloc = b.st[0], nx = b.st[1];
        if (nloc == 0u) { xcd_barrier_complete(bar, b.x, nloc, nx); b.st[0] = nloc; b.st[1] = nx; }
        const unsigned old = xb_add(&bar[XB_XSUB(b.x)], 1u);
        const unsigned gen = old / nloc;
        if (old + 1u == (gen + 1u) * nloc) {
            __builtin_amdgcn_fence(__ATOMIC_RELEASE, "agent");
            asm volatile("s_waitcnt vmcnt(0)" ::: "memory");
            const unsigned og = xb_add(&bar[XB_TOP], 1u);
            const unsigned tg = og / nx;
            if (og + 1u == (tg + 1u) * nx) xb_add(&bar[XB_TOPGEN], 1u);
            else XB_SPIN(xb_ld(&bar[XB_TOPGEN]) == tg, bar);
            __builtin_amdgcn_fence(__ATOMIC_ACQUIRE, "agent");
            xb_add(&bar[XB_XGEN(b.x)], 1u);
            asm volatile("s_waitcnt vmcnt(0)" ::: "memory");
        } else {
            XB_SPIN(xb_ld(&bar[XB_XGEN(b.x)]) == gen, bar);
            __builtin_amdgcn_fence(__ATOMIC_ACQUIRE, "agent");
            asm volatile("s_waitcnt vmcnt(0)" ::: "memory");
        }
    }
    __syncthreads();
}

constexpr int NWAVES = 8;
constexpr int DM = 4096, SEQ = 16384, CTXL = 256, MTOT = SEQ + CTXL, DEPTH = 4, DFF = 6144, INC = 8192, RMOD = 256, NMOD = 9, MODW = NMOD * DM;
constexpr int CTX_PM = SEQ / 256;
constexpr float EPS = 1e-6f;
constexpr int C_QA = 0, C_KA = 2048, C_VA = 2560, C_QB = 3072, C_KB = 4096, C_VB = 5120, C_U = 6144, C_V = 7168;
constexpr int O_A = 0, O_B = 2048, O_C = 3072;
constexpr size_t MiB = 1u << 20;
constexpr size_t WS_CTL = 0, CTL_ZERO_BYTES = 1 * MiB;
constexpr size_t WS_MOD = 1 * MiB;
constexpr size_t WS_ROPE = 3 * MiB;
constexpr size_t WS_XR = 4 * MiB;
constexpr size_t WS_H = 264 * MiB;
constexpr size_t WS_ACT = 394 * MiB;
constexpr size_t WS_PROJ = 589 * MiB;
constexpr size_t WS_CAT = 849 * MiB;
#ifndef NSLAB_N
#define NSLAB_N 8
#endif
constexpr int NSLAB = NSLAB_N;
constexpr size_t WS_W1 = 1024 * MiB;
constexpr size_t WS_W2 = 1792 * MiB;
constexpr size_t WS_WMI = 2176 * MiB;
constexpr size_t WS_WMO = 2432 * MiB;
constexpr size_t WS_SLAB = 2560 * MiB;
constexpr size_t WS_DL = 2688 * MiB;
constexpr size_t WS_SLAB1 = 2944 * MiB;
constexpr size_t WS_SLAB2 = 2976 * MiB;
#ifndef NSL1_N
#define NSL1_N 4
#endif
#ifndef NSL2_N
#define NSL2_N 8
#endif
constexpr int NSL1 = NSL1_N, NSL2 = NSL2_N;
constexpr size_t WS_END = 3040 * MiB;
static_assert(WS_XR + (size_t)MTOT * DM * 4 <= WS_H && WS_H + (size_t)MTOT * DM * 2 <= WS_ACT && WS_ACT + (size_t)MTOT * DFF * 2 <= WS_PROJ && WS_PROJ + (size_t)MTOT * INC * 2 <= WS_CAT &&
              WS_CAT + (size_t)MTOT * DM * 2 <= WS_W1 && WS_W1 + 8ull * 2 * DFF * DM * 2 <= WS_W2 && WS_W2 + 8ull * DM * DFF * 2 <= WS_WMI && WS_WMI + 4ull * INC * DM * 2 <= WS_WMO &&
              WS_WMO + 4ull * DM * DM * 2 <= WS_SLAB && WS_SLAB + 2 * (size_t)NSLAB * 256 * DM * 4 <= WS_DL && WS_DL + 2 * (size_t)SEQ * DM * 2 <= WS_SLAB1 && WS_SLAB1 + (size_t)NSL1 * 256 * 2 * DFF * 2 <= WS_SLAB2 && WS_SLAB2 + (size_t)NSL2 * 256 * INC * 2 <= WS_END && WS_MOD + (size_t)DEPTH * 2 * MODW * 4 <= WS_ROPE && WS_ROPE + 256 * 32 * 2 * 4 <= WS_XR, "d_ws map");
constexpr int CW_BAR = 4096;
constexpr int CW_T = 16384;
constexpr int RING_OFF = 0, RING_BYTES = 131072;
constexpr int LDSCTL_OFF = RING_BYTES, MISC_OFF = LDSCTL_OFF + 320;
constexpr int LDS_BYTES = 147456;
static_assert(MISC_OFF + 128 <= LDS_BYTES, "LDS map");

__device__ const float INV_FREQ[32] = {
  1.000000000e+00f, 7.498942614e-01f, 5.623413324e-01f, 4.216965139e-01f, 3.162277639e-01f, 2.371373773e-01f, 1.778279394e-01f, 1.333521307e-01f,
  1.000000015e-01f, 7.498941571e-02f, 5.623413250e-02f, 4.216965288e-02f, 3.162277490e-02f, 2.371373773e-02f, 1.778279431e-02f, 1.333521493e-02f,
  9.999999776e-03f, 7.498941850e-03f, 5.623413250e-03f, 4.216964822e-03f, 3.162277630e-03f, 2.371373586e-03f, 1.778279431e-03f, 1.333521446e-03f,
  1.000000047e-03f, 7.498942432e-04f, 5.623413017e-04f, 4.216965172e-04f, 3.162277571e-04f, 2.371373703e-04f, 1.778279402e-04f, 1.333521504e-04f };

struct Frame {
    LAS unsigned char* lds;
    volatile LAS unsigned* MISC;
    gu32* ctl;
    int vcu, G, wid;
    float* out;
    unsigned char* ws;
};
enum { I_X = 0, I_C, I_CTX, I_CCTX, I_NORMG, I_WDOWN, I_WUP, I_MODB, I_FWIN, I_FWOUT, I_MWIN, I_MWOUT, I_QKG, I_RPB, I_SGUG, I_SGUW, I_SGUB, I_FING };

__device__ __forceinline__ const float* in_ptr(const Frame& F, int k) {
    unsigned a_ = (unsigned)LDSCTL_OFF + 8u * (unsigned)k; asm volatile("" : "+s"(a_));
    const volatile LAS unsigned* t = (const volatile LAS unsigned*)(uintptr_t)a_;
    const unsigned lo = __builtin_amdgcn_readfirstlane(t[0]), hi = __builtin_amdgcn_readfirstlane(t[1]);
    return (const float*)(const GAS float*)(((unsigned long long)hi << 32) | lo);
}
__device__ __forceinline__ unsigned char* wsl(const Frame& F) { GAS unsigned char* p = (GAS unsigned char*)F.ws; asm volatile("" : "+s"(p)); return (unsigned char*)p; }
#define P_MOD(F)  ((float*)(wsl(F) + WS_MOD))
#define P_ROPE(F) ((float*)(wsl(F) + WS_ROPE))
#define P_XR(F)   ((float*)(wsl(F) + WS_XR))
#define P_H(F)    ((bf16*)(wsl(F) + WS_H))
#define P_ACT(F)  ((bf16*)(wsl(F) + WS_ACT))
#define P_PROJ(F) ((bf16*)(wsl(F) + WS_PROJ))
#define P_CAT(F)  ((bf16*)(wsl(F) + WS_CAT))
#define P_SLAB(F) ((bf16*)(wsl(F) + WS_SLAB))
#define P_DL(F)   ((bf16*)(wsl(F) + WS_DL))
#define P_SLAB1(F) ((bf16*)(wsl(F) + WS_SLAB1))
#define P_SLAB2(F) ((bf16*)(wsl(F) + WS_SLAB2))
#define P_W1(F)   ((bf16*)(wsl(F) + WS_W1))
#define P_W2(F)   ((bf16*)(wsl(F) + WS_W2))
#define P_WMI(F)  ((bf16*)(wsl(F) + WS_WMI))
#define P_WMO(F)  ((bf16*)(wsl(F) + WS_WMO))
__device__ __forceinline__ int lane_id() { return (int)(threadIdx.x & 63); }
#define PH_IDS() int tid_ = threadIdx.x; asm volatile("" : "+v"(tid_)); const int tid = tid_, lane = tid & 63, wave = __builtin_amdgcn_readfirstlane(tid >> 6); (void)tid; (void)lane; (void)wave

__device__ __forceinline__ float wave_sum(float v) {
#pragma unroll
    for (int o = 1; o < 64; o <<= 1) v += __shfl_xor(v, o);
    return v;
}
__device__ __forceinline__ unsigned pkbf(float lo, float hi) { unsigned r; asm("v_cvt_pk_bf16_f32 %0, %1, %2" : "=v"(r) : "v"(lo), "v"(hi)); return r; }
__device__ __forceinline__ float bf_lo(unsigned w) { return __builtin_bit_cast(float, w << 16); }
__device__ __forceinline__ float bf_hi(unsigned w) { return __builtin_bit_cast(float, w & 0xffff0000u); }
__device__ __forceinline__ float gelu_tanh(float x) {
    const float z = 0.7978845608028654f * (x + 0.044715f * x * x * x);
    return x * __builtin_amdgcn_rcpf(1.f + __builtin_amdgcn_exp2f(z * -2.8853900817779268f));
}

#ifndef TR_NT
#define TR_NT 0
#endif
#if TR_NT
#define TR_LOAD(p) __builtin_nontemporal_load(p)
#define TR_STORE(v, p) __builtin_nontemporal_store(v, p)
#else
#ifndef TR_NT_LD
#define TR_NT_LD 1
#endif
#define TR_LOAD(p) (TR_NT_LD ? __builtin_nontemporal_load(p) : *(p))
#define TR_STORE(v, p) (*(p) = (v))
#endif
__device__ __forceinline__ void transpose_item(const float* W, int K, int N, bf16* WT, int k0, int n0, int drow0, LAS float* scr, int lane) {
    { float v[32];
      const float* wp = W + (size_t)(k0 + (lane >> 5)) * N + n0 + (lane & 31);
#pragma unroll
      for (int i = 0; i < 32; ++i) v[i] = TR_LOAD(wp + (size_t)(2 * i) * N);
#pragma unroll
      for (int i = 0; i < 32; ++i) scr[(2 * i + (lane >> 5)) * 33 + (lane & 31)] = v[i]; }
    LDS_WAIT(); asm volatile("" ::: "memory");
    const int c = lane & 7;
#pragma unroll
    for (int j = 0; j < 4; ++j) { const int n = (lane >> 3) + 8 * j; const LAS float* s = scr + (8 * c) * 33 + n;
        v4u o; o.x = pkbf(s[0 * 33], s[1 * 33]); o.y = pkbf(s[2 * 33], s[3 * 33]); o.z = pkbf(s[4 * 33], s[5 * 33]); o.w = pkbf(s[6 * 33], s[7 * 33]);
        TR_STORE(o, (GAS v4u*)(WT + (size_t)(drow0 + n) * K + k0 + 8 * c)); }
    LDS_WAIT(); asm volatile("" ::: "memory");
}

__device__ __forceinline__ void p0a(Frame& F, bool full) {
    PH_IDS();
    bf16* const W1 = P_W1(F); bf16* const W2 = P_W2(F); bf16* const WMI = P_WMI(F); bf16* const WMO = P_WMO(F); float* const ROPE = P_ROPE(F);
    LAS float* scr = (LAS float*)(F.lds + RING_OFF + wave * 16384);
    const int gw = F.vcu * NWAVES + wave, NGW = F.G * NWAVES;
    constexpr int I_W1 = (DM / 64) * (2 * DFF / 32), I_W2 = (DFF / 64) * (DM / 32), I_MI = (DM / 64) * (INC / 32), I_MO = (DM / 64) * (DM / 32);
    constexpr int N_W1 = 8 * I_W1, N_W2 = 8 * I_W2, N_MI = 4 * I_MI, N_MO = 4 * I_MO, NITEMS = N_W1 + N_W2 + N_MI + N_MO;
    for (int it = gw; it < NITEMS; it += NGW) {
        int r = it;
        if (r < N_W1) { const int mat = r / I_W1; r -= mat * I_W1; const int nblk = 2 * DFF / 32, kb = r / nblk, nb = r % nblk, n0 = 32 * nb;
            const int drow0 = n0 < DFF ? ((n0 >> 7) * 256 + (n0 & 127)) : (((n0 - DFF) >> 7) * 256 + 128 + ((n0 - DFF) & 127));
            transpose_item(in_ptr(F, I_FWIN) + (size_t)mat * DM * 2 * DFF, DM, 2 * DFF, W1 + (size_t)mat * 2 * DFF * DM, 64 * kb, n0, drow0, scr, lane); continue; }
        r -= N_W1;
        if (r < N_W2) { const int mat = r / I_W2; r -= mat * I_W2; const int nblk = DM / 32, kb = r / nblk, nb = r % nblk;
            transpose_item(in_ptr(F, I_FWOUT) + (size_t)mat * DFF * DM, DFF, DM, W2 + (size_t)mat * DM * DFF, 64 * kb, 32 * nb, 32 * nb, scr, lane); continue; }
        r -= N_W2;
        if (r < N_MI) { const int mat = r / I_MI; r -= mat * I_MI; const int nblk = INC / 32, kb = r / nblk, nb = r % nblk;
            transpose_item(in_ptr(F, I_MWIN) + (size_t)mat * DM * INC, DM, INC, WMI + (size_t)mat * INC * DM, 64 * kb, 32 * nb, 32 * nb, scr, lane); continue; }
        r -= N_MI;
        { const int mat = r / I_MO; r -= mat * I_MO; const int nblk = DM / 32, kb = r / nblk, nb = r % nblk;
            transpose_item(in_ptr(F, I_MWOUT) + (size_t)mat * DM * DM, DM, DM, WMO + (size_t)mat * DM * DM, 64 * kb, 32 * nb, 32 * nb, scr, lane); }
    }
    if (!full) return;
    { const int gid = F.vcu * (NWAVES * 64) + tid;
      if (gid < 256 * 32) { const int pos = gid >> 5, i = gid & 31; const float angf = (float)pos * INV_FREQ[i]; const double a = (double)angf;
        const double nq = __builtin_rint(a * 0.63661977236758134308); const double rr = (a - nq * 1.5707963267948966192) - nq * 6.123233995736766e-17; const double r2 = rr * rr;
        const double sn = rr * (1.0 + r2 * (-1.0 / 6 + r2 * (1.0 / 120 + r2 * (-1.0 / 5040 + r2 * (1.0 / 362880 + r2 * (-1.0 / 39916800 + r2 * (1.0 / 6227020800.0)))))));
        const double cs = 1.0 + r2 * (-0.5 + r2 * (1.0 / 24 + r2 * (-1.0 / 720 + r2 * (1.0 / 40320 + r2 * (-1.0 / 3628800 + r2 * (1.0 / 479001600.0 + r2 * (-1.0 / 87178291200.0)))))));
        const int q = ((int)nq) & 3; const double c_ = (q == 0) ? cs : (q == 1) ? -sn : (q == 2) ? -cs : sn; const double s_ = (q == 0) ? sn : (q == 1) ? cs : (q == 2) ? -sn : -cs;
        ROPE[2 * gid] = (float)c_; ROPE[2 * gid + 1] = (float)s_; } }
    __syncthreads();
    for (int item = F.vcu; item < 256; item += F.G) {
        const int l = item >> 6, ch = item & 63; const float* Wd = in_ptr(F, I_WDOWN) + (size_t)l * DM * RMOD;
        f32x4 a0 = {0.f, 0.f, 0.f, 0.f}, a1 = a0;
#pragma unroll
        for (int i = 0; i < 8; ++i) { const int d = ch * 64 + wave * 8 + i; const float cv = in_ptr(F, I_C)[d], cc = in_ptr(F, I_CCTX)[d];
            const float s0 = cv / (1.f + __expf(-cv)), s1 = cc / (1.f + __expf(-cc)); const f32x4 w = *(const GAS f32x4*)(Wd + (size_t)d * RMOD + 4 * lane);
            a0 += w * s0; a1 += w * s1; }
        LAS float* red = (LAS float*)(F.lds + RING_OFF) + wave * 512;
        *(LAS f32x4*)(red + 4 * lane) = a0; *(LAS f32x4*)(red + 256 + 4 * lane) = a1;
        __syncthreads();
        { const LAS float* rb = (const LAS float*)(F.lds + RING_OFF) + tid; float s = 0.f;
#pragma unroll
          for (int w = 0; w < 8; ++w) s += rb[w * 512];
          atomicAdd((float*)(F.ctl + CW_T) + l * 512 + tid, s); }
        __syncthreads();
    }
}
__device__ __forceinline__ void p0b(Frame& F) {
    PH_IDS();
    float* const MOD = P_MOD(F);
    LAS float* tl = (LAS float*)(F.lds + RING_OFF); LAS f32x4* part = (LAS f32x4*)(F.lds + RING_OFF + 4096);
    for (int item = F.vcu; item < DEPTH * 36; item += F.G) {
        const int l = item / 36, jb = item % 36;
        tl[tid] = ((const GAS float*)(F.ctl + CW_T))[l * 512 + tid];
        __syncthreads();
        const int jl = tid & 255, rh = tid >> 8, j = (jb * 256 + jl) * 4;
        const float* Wu = in_ptr(F, I_WUP) + (size_t)l * RMOD * MODW + j;
        f32x4 a0 = {0.f, 0.f, 0.f, 0.f}, a1 = a0;
#pragma unroll 8
        for (int r = rh * 128; r < rh * 128 + 128; ++r) { const f32x4 w = *(const GAS f32x4*)(Wu + (size_t)r * MODW); a0 += w * tl[r]; a1 += w * tl[256 + r]; }
        if (rh == 1) { part[jl * 2] = a0; part[jl * 2 + 1] = a1; }
        __syncthreads();
        if (rh == 0) { const f32x4 b = *(const GAS f32x4*)(in_ptr(F, I_MODB) + (size_t)l * MODW + j); a0 += part[jl * 2] + b; a1 += part[jl * 2 + 1] + b;
            *(GAS f32x4*)(MOD + (size_t)(l * 2 + 0) * MODW + j) = a0; *(GAS f32x4*)(MOD + (size_t)(l * 2 + 1) * MODW + j) = a1; }
        __syncthreads();
    }
}
template <bool FINAL>
__device__ __forceinline__ void norm_phase(Frame& F, const float* g, const float* modl, const float* modc, int i_shift, int i_scale, bf16* H, float* out, int mrows, const float* xlat  , const float* xctx  , int nslab, int npend  , bool wb  , bool down  ) {
    PH_IDS();
    float* const XR = P_XR(F); const bf16* const SLAB = P_SLAB(F); const bf16* const DL = P_DL(F);
    LAS float* gs = (LAS float*)(F.lds + RING_OFF); LAS float* sh = gs + DM;
    { float ga[DM / (NWAVES * 64)], sa[DM / (NWAVES * 64)], ha[DM / (NWAVES * 64)];
#pragma unroll
      for (int i = 0; i < DM / (NWAVES * 64); ++i) { const int j = tid + i * NWAVES * 64; ga[i] = ((const GAS float*)g)[j];
          if (!FINAL) { sa[i] = ((const GAS float*)modl)[i_scale * DM + j]; ha[i] = ((const GAS float*)modl)[i_shift * DM + j]; } else { sa[i] = 0.f; ha[i] = 0.f; } }
#pragma unroll
      for (int i = 0; i < DM / (NWAVES * 64); ++i) { const int j = tid + i * NWAVES * 64; gs[j] = ga[i] * (1.f + sa[i]); if (!FINAL) sh[j] = ha[i]; } }
    __syncthreads();
    const bool heavy = !FINAL && (mrows > SEQ) && (nslab > 0);
    const int mstep = F.G * NWAVES, mend = mrows;
    int mstat = F.vcu * NWAVES + wave, mc = SEQ + F.vcu;
    LAS unsigned* const rowcnt = (LAS unsigned*)(F.lds + RING_OFF + 32768);
    if (heavy) { if (tid == 0) *rowcnt = 0u; __syncthreads(); }
    for (;;) {
        int m;
#ifndef NORM_DOWN
#define NORM_DOWN 1
#endif
        if (!heavy) { m = mstat; mstat += mstep; if (m >= mend) break;
                      if (NORM_DOWN && down && m < SEQ) { const int w0 = F.vcu * NWAVES + wave, cntw = (SEQ - w0 + mstep - 1) / mstep, k_ = (m - w0) / mstep; m = w0 + (cntw - 1 - k_) * mstep; } }
        else if (wave == 7 && mc < MTOT) { m = mc; mc += F.G; }
        else { unsigned i_ = 0u; if (lane == 0) i_ = __hip_atomic_fetch_add(rowcnt, 1u, __ATOMIC_RELAXED, __HIP_MEMORY_SCOPE_WORKGROUP);
               const int ii_ = (int)__builtin_amdgcn_readfirstlane(i_), cnt_ = (SEQ - F.vcu + F.G - 1) / F.G; if (ii_ >= cnt_) break;
               m = F.vcu + ((NORM_DOWN && down) ? cnt_ - 1 - ii_ : ii_) * F.G; }
        asm volatile("" ::: "memory");
        GAS f32x4* xr = (GAS f32x4*)(XR + (size_t)m * DM) + lane;
        const GAS f32x4* xin = (const GAS f32x4*)(m < SEQ ? xlat + (size_t)m * DM : xctx + (size_t)(m - SEQ) * DM) + lane;
        f32x4 v[16]; float ss = 0.f;
#pragma unroll
#ifndef H_NT
#define H_NT 0
#endif
#ifndef DL_NT
#define DL_NT 1
#endif
#ifndef NORM_NT_ST
#define NORM_NT_ST 1
#endif
#ifndef NORM_NT
#define NORM_NT 1
#endif
        for (int j = 0; j < 16; ++j) v[j] = NORM_NT ? __builtin_nontemporal_load(&xin[64 * j]) : xin[64 * j];
#ifndef NO_DADD
        if (npend > 0 && m < SEQ) {
            const GAS unsigned long long* dp0 = (const GAS unsigned long long*)(DL + (size_t)m * DM) + lane;
            const GAS unsigned long long* dp1 = (const GAS unsigned long long*)(DL + (size_t)SEQ * DM + (size_t)m * DM) + lane;
            unsigned long long d0[16], d1[16];
#pragma unroll
            for (int j = 0; j < 16; ++j) d0[j] = DL_NT ? __builtin_nontemporal_load(&dp0[64 * j]) : dp0[64 * j];
            if (npend > 1) {
#pragma unroll
                for (int j = 0; j < 16; ++j) d1[j] = DL_NT ? __builtin_nontemporal_load(&dp1[64 * j]) : dp1[64 * j];
            } else {
#pragma unroll
                for (int j = 0; j < 16; ++j) d1[j] = 0ull;
            }
#pragma unroll
            for (int j = 0; j < 16; ++j) { const unsigned lo = (unsigned)d0[j], hi_ = (unsigned)(d0[j] >> 32), lo1 = (unsigned)d1[j], hi1 = (unsigned)(d1[j] >> 32);
                v[j].x += bf_lo(lo) + bf_lo(lo1); v[j].y += bf_hi(lo) + bf_hi(lo1); v[j].z += bf_lo(hi_) + bf_lo(hi1); v[j].w += bf_hi(hi_) + bf_hi(hi1); }
            if (!FINAL && wb) {
#pragma unroll
                for (int j = 0; j < 16; ++j) { if (NORM_NT_ST) __builtin_nontemporal_store(v[j], &xr[64 * j]); else xr[64 * j] = v[j]; } }
        }
#endif
        if (!FINAL && m >= SEQ && nslab > 0) {
            for (int s_ = 0; s_ < nslab; ++s_) { const GAS unsigned long long* sp = (const GAS unsigned long long*)(SLAB + ((size_t)s_ * 256 + (m - SEQ)) * DM) + lane;
#pragma unroll
                for (int j = 0; j < 16; ++j) { const unsigned long long d = sp[64 * j]; const unsigned lo = (unsigned)d, hi_ = (unsigned)(d >> 32);
                    v[j].x += bf_lo(lo); v[j].y += bf_hi(lo); v[j].z += bf_lo(hi_); v[j].w += bf_hi(hi_); } }
#pragma unroll
            for (int j = 0; j < 16; ++j) xr[64 * j] = v[j];
        }
#pragma unroll
        for (int j = 0; j < 16; ++j) ss += (v[j].x * v[j].x + v[j].y * v[j].y) + (v[j].z * v[j].z + v[j].w * v[j].w);
        const float rstd = 1.f / sqrtf(wave_sum(ss) * (1.f / DM) + EPS);
        if (FINAL) { GAS f32x4* o = (GAS f32x4*)(out + (size_t)m * DM) + lane;
#pragma unroll
            for (int j = 0; j < 16; ++j) o[64 * j] = v[j] * rstd * *(const LAS f32x4*)(gs + 256 * j + 4 * lane);
        } else {
            GAS unsigned long long* o8 = (GAS unsigned long long*)(H + (size_t)m * DM) + lane;
            if (m < SEQ) {
#pragma unroll
                for (int j = 0; j < 16; ++j) { const f32x4 y = v[j] * rstd * *(const LAS f32x4*)(gs + 256 * j + 4 * lane) + *(const LAS f32x4*)(sh + 256 * j + 4 * lane);
                    const unsigned long long pk_ = (unsigned long long)pkbf(y.x, y.y) | ((unsigned long long)pkbf(y.z, y.w) << 32); if (H_NT) __builtin_nontemporal_store(pk_, &o8[64 * j]); else o8[64 * j] = pk_; }
            } else {
                int lc_ = lane; asm volatile("" : "+v"(lc_));
#pragma unroll
                for (int j = 0; j < 16; ++j) { const int c = 256 * j + 4 * lc_; const f32x4 gg = *(const GAS f32x4*)(g + c) * (*(const GAS f32x4*)(modc + i_scale * DM + c) + 1.f);
                    const f32x4 y = v[j] * rstd * gg + *(const GAS f32x4*)(modc + i_shift * DM + c);
                    o8[64 * j] = (unsigned long long)pkbf(y.x, y.y) | ((unsigned long long)pkbf(y.z, y.w) << 32);
                    if ((j & 3) == 3) asm volatile("" ::: "memory"); }
            }
        }
    }
}
__device__ __forceinline__ void ctx_fix_ffn(Frame& F) {
    PH_IDS();
    const bf16* const SL = P_SLAB1(F); bf16* const ACT = P_ACT(F);
    for (int r = F.vcu; r < CTXL; r += F.G)
        for (int c = tid; c < DFF / 8; c += NWAVES * 64) { const int j0 = 8 * c, ca = ((j0 >> 7) << 8) + (j0 & 127);
            float a[8] = {0.f, 0.f, 0.f, 0.f, 0.f, 0.f, 0.f, 0.f}, b[8] = {0.f, 0.f, 0.f, 0.f, 0.f, 0.f, 0.f, 0.f};
#pragma unroll
            for (int s_ = 0; s_ < NSL1; ++s_) { const bf16* p = SL + ((size_t)s_ * 256 + r) * (2 * DFF) + ca; const v4u wa = *(const GAS v4u*)p, wb = *(const GAS v4u*)(p + 128);
                a[0] += bf_lo(wa.x); a[1] += bf_hi(wa.x); a[2] += bf_lo(wa.y); a[3] += bf_hi(wa.y); a[4] += bf_lo(wa.z); a[5] += bf_hi(wa.z); a[6] += bf_lo(wa.w); a[7] += bf_hi(wa.w);
                b[0] += bf_lo(wb.x); b[1] += bf_hi(wb.x); b[2] += bf_lo(wb.y); b[3] += bf_hi(wb.y); b[4] += bf_lo(wb.z); b[5] += bf_hi(wb.z); b[6] += bf_lo(wb.w); b[7] += bf_hi(wb.w); }
            float o[8];
#pragma unroll
            for (int e = 0; e < 8; ++e) o[e] = (a[e] * __builtin_amdgcn_rcpf(1.f + __builtin_amdgcn_exp2f(a[e] * -1.4426950408889634f))) * b[e];
            v4u w; w.x = pkbf(o[0], o[1]); w.y = pkbf(o[2], o[3]); w.z = pkbf(o[4], o[5]); w.w = pkbf(o[6], o[7]);
            *(GAS v4u*)(ACT + (size_t)(SEQ + r) * DFF + j0) = w; }
}
__device__ __forceinline__ void ctx_fix_proj(Frame& F) {
    PH_IDS();
    const bf16* const SL = P_SLAB2(F); bf16* const PROJ = P_PROJ(F);
    for (int r = F.vcu; r < CTXL; r += F.G)
        for (int c = tid; c < INC / 8; c += NWAVES * 64) { const int j0 = 8 * c;
            float a[8] = {0.f, 0.f, 0.f, 0.f, 0.f, 0.f, 0.f, 0.f};
#pragma unroll
            for (int s_ = 0; s_ < NSL2; ++s_) { const v4u wa = *(const GAS v4u*)(SL + ((size_t)s_ * 256 + r) * INC + j0);
                a[0] += bf_lo(wa.x); a[1] += bf_hi(wa.x); a[2] += bf_lo(wa.y); a[3] += bf_hi(wa.y); a[4] += bf_lo(wa.z); a[5] += bf_hi(wa.z); a[6] += bf_lo(wa.w); a[7] += bf_hi(wa.w); }
            v4u w; w.x = pkbf(a[0], a[1]); w.y = pkbf(a[2], a[3]); w.z = pkbf(a[4], a[5]); w.w = pkbf(a[6], a[7]);
            *(GAS v4u*)(PROJ + (size_t)(SEQ + r) * INC + j0) = w; }
}
__device__ __forceinline__ void qknorm_rows(Frame& F, const float* qkg  , bool skip_lat_q  ) {
    PH_IDS();
    bf16* const PROJ = P_PROJ(F); const float* const ROPE = P_ROPE(F);
    const int gw = F.vcu * NWAVES + wave, NGW = F.G * NWAVES, hq = lane >> 4, q = lane & 15;
    for (int m = gw + ((MTOT - 1 - gw) / NGW) * NGW; m >= 0; m -= NGW) {
        bf16* prow = PROJ + (size_t)m * INC;
        const int pos = (q < 8) ? (m >> 6) : (m & 63);
        f32x4 cs[4];
        if (m < SEQ) { const GAS f32x4* tb = (const GAS f32x4*)(ROPE + (size_t)(pos * 32 + (q & 3) * 8) * 2);
#pragma unroll
            for (int e = 0; e < 4; ++e) cs[e] = tb[e]; }
        v4u raws[5];
        const int st0 = (skip_lat_q && m < SEQ) ? 4 : 0;
#pragma unroll
        for (int st = 0; st < 5; ++st) if (st >= st0) raws[st] = __builtin_nontemporal_load((const GAS v4u*)(prow + (st * 4 + hq) * 128 + 8 * q));
#pragma unroll
        for (int st = 0; st < 5; ++st) { if (st < st0) continue;
            const int hh = st * 4 + hq; GAS v4u* p = (GAS v4u*)(prow + hh * 128 + 8 * q); const v4u raw = raws[st];
            float v[8] = {bf_lo(raw.x), bf_hi(raw.x), bf_lo(raw.y), bf_hi(raw.y), bf_lo(raw.z), bf_hi(raw.z), bf_lo(raw.w), bf_hi(raw.w)};
            float ss = 0.f;
#pragma unroll
            for (int e = 0; e < 8; ++e) ss += v[e] * v[e];
            ss += __shfl_xor(ss, 1); ss += __shfl_xor(ss, 2); ss += __shfl_xor(ss, 4); ss += __shfl_xor(ss, 8);
            const float rstd = 1.f / sqrtf(ss * (1.f / 128.f) + EPS);
            const float* gp = qkg + (st == 4 ? 128 : 0) + 8 * q; const f32x4 g0 = *(const f32x4*)gp, g1 = *(const f32x4*)(gp + 4);
            const float gg[8] = {g0.x, g0.y, g0.z, g0.w, g1.x, g1.y, g1.z, g1.w};
#pragma unroll
            for (int e = 0; e < 8; ++e) v[e] = v[e] * rstd * gg[e];
            if (m < SEQ) {
#pragma unroll
                for (int e = 0; e < 8; ++e) { const float yp = __shfl_xor(v[e], 4); const float c = (e & 1) ? cs[e >> 1].z : cs[e >> 1].x, s = (e & 1) ? cs[e >> 1].w : cs[e >> 1].y;
                    v[e] = (q & 4) ? (v[e] * c + yp * s) : (v[e] * c - yp * s); } }
            v4u o; o.x = pkbf(v[0], v[1]); o.y = pkbf(v[2], v[3]); o.z = pkbf(v[4], v[5]); o.w = pkbf(v[6], v[7]); *p = o;
        }
    }
}
__device__ __forceinline__ bool attn_noshift_ok(const float* qkg) {
    const int lane = lane_id();
    float gq = fmaxf(fabsf(qkg[lane]), fabsf(qkg[64 + lane])), gk = fmaxf(fabsf(qkg[128 + lane]), fabsf(qkg[192 + lane]));
#pragma unroll
    for (int o = 1; o < 64; o <<= 1) { gq = fmaxf(gq, __shfl_xor(gq, o)); gk = fmaxf(gk, __shfl_xor(gk, o)); }
    const float M = 11.313708499f * gq * gk;
#ifdef FORCE_ONLINE_MAX
    return false;
#endif
    return __builtin_amdgcn_readfirstlane((M <= 38.f) ? 1 : 0) != 0;
}
constexpr int SV_PITCH = 132;
constexpr int VNT_PITCH = 136;
__device__ __forceinline__ void sgu_unit(Frame& F, int n, int g, const float* gv  , const float* Wsl  , const float* bsl  ) {
    LAS bf16* VNT = (LAS bf16*)(F.lds + RING_OFF);
    PH_IDS();
    const bf16* const PROJ = P_PROJ(F); bf16* const CAT = P_CAT(F);
    const size_t row0 = (size_t)n * 128;
    __syncthreads();
#pragma unroll
    for (int i = 0; i < 4; ++i) { const int pid = tid + 512 * i, q = pid >> 4, c0 = (pid & 15) * 8;
        const v4u raw = __builtin_nontemporal_load((const GAS v4u*)(PROJ + (row0 + q) * INC + C_V + g * 128 + c0));
        float v[8] = {bf_lo(raw.x), bf_hi(raw.x), bf_lo(raw.y), bf_hi(raw.y), bf_lo(raw.z), bf_hi(raw.z), bf_lo(raw.w), bf_hi(raw.w)};
        float ss = 0.f;
#pragma unroll
        for (int e = 0; e < 8; ++e) { v[e] = gelu_tanh(v[e]); ss += v[e] * v[e]; }
        ss += __shfl_xor(ss, 1); ss += __shfl_xor(ss, 2); ss += __shfl_xor(ss, 4); ss += __shfl_xor(ss, 8);
        const float rstd = 1.f / sqrtf(ss * (1.f / 128.f) + EPS);
        const float* gp = gv + g * 128 + c0; const f32x4 g0 = *(const f32x4*)gp, g1 = *(const f32x4*)(gp + 4);
        const float gg[8] = {g0.x, g0.y, g0.z, g0.w, g1.x, g1.y, g1.z, g1.w};
#pragma unroll
        for (int e = 0; e < 8; ++e) { const unsigned pk = pkbf(v[e] * rstd * gg[e], 0.f); VNT[(c0 + e) * VNT_PITCH + q] = (bf16)(pk & 0xffffu); } }
    __syncthreads();
    const int pb = wave & 3, ch = wave >> 2, r32 = lane & 31, hi = lane >> 5;
    att::f32x16 acc0 = {}, acc1 = {};
    const float* wrow = Wsl + ((size_t)g * 128 + pb * 32 + r32) * 128 + 8 * hi;
#pragma unroll
    for (int ks = 0; ks < 8; ++ks) {
        const f32x4 w0 = *(const f32x4*)(wrow + 16 * ks), w1 = *(const f32x4*)(wrow + 16 * ks + 4);
        v4u aw; aw.x = pkbf(w0.x, w0.y); aw.y = pkbf(w0.z, w0.w); aw.z = pkbf(w1.x, w1.y); aw.w = pkbf(w1.z, w1.w);
        const bf16x8 af = __builtin_bit_cast(bf16x8, aw);
        const bf16x8 b0 = *(const LAS bf16x8*)(VNT + (64 * ch + r32) * VNT_PITCH + 16 * ks + 8 * hi);
        const bf16x8 b1 = *(const LAS bf16x8*)(VNT + (64 * ch + 32 + r32) * VNT_PITCH + 16 * ks + 8 * hi);
        acc0 = __builtin_amdgcn_mfma_f32_32x32x16_bf16(af, b0, acc0, 0, 0, 0);
        acc1 = __builtin_amdgcn_mfma_f32_32x32x16_bf16(af, b1, acc1, 0, 0, 0); }
    LAS float* SVL = (LAS float*)(F.lds + RING_OFF + 40960);
#pragma unroll
    for (int r = 0; r < 16; ++r) { const int p = pb * 32 + att::crow(r, hi); const float bs = bsl[g * 128 + p];
        SVL[p * SV_PITCH + 64 * ch + r32] = acc0[r] + bs; SVL[p * SV_PITCH + 64 * ch + 32 + r32] = acc1[r] + bs; }
    __syncthreads();
#pragma unroll
    for (int i = 0; i < 4; ++i) { const int cid = tid + 512 * i, p = cid >> 4, c0 = (cid & 15) * 8;
        const v4u raw = __builtin_nontemporal_load((const GAS v4u*)(PROJ + (row0 + p) * INC + C_U + g * 128 + c0));
        const f32x4 s0 = *(const LAS f32x4*)(SVL + p * SV_PITCH + c0), s1 = *(const LAS f32x4*)(SVL + p * SV_PITCH + c0 + 4);
        v4u o; o.x = pkbf(gelu_tanh(bf_lo(raw.x)) * s0.x, gelu_tanh(bf_hi(raw.x)) * s0.y); o.y = pkbf(gelu_tanh(bf_lo(raw.y)) * s0.z, gelu_tanh(bf_hi(raw.y)) * s0.w);
        o.z = pkbf(gelu_tanh(bf_lo(raw.z)) * s1.x, gelu_tanh(bf_hi(raw.z)) * s1.y); o.w = pkbf(gelu_tanh(bf_lo(raw.w)) * s1.z, gelu_tanh(bf_hi(raw.w)) * s1.w);
        *(GAS v4u*)(CAT + (row0 + p) * DM + O_C + g * 128 + c0) = o; }
}

#ifndef ATT1_SDEPTH
#define ATT1_SDEPTH 1
#endif
#ifndef ATT0_SDEPTH
#define ATT0_SDEPTH 1
#endif
#ifndef G1_ALIGN
#define G1_ALIGN true
#endif
#ifndef MINI_FIRST
#define MINI_FIRST 0
#endif
#ifndef RESID_ALIGN
#define RESID_ALIGN true
#endif
#ifndef INPROJ_COLMAJOR
#define INPROJ_COLMAJOR 0
#endif
#ifndef GEMM_REV
#define GEMM_REV 0
#endif
#ifndef PROBE_DBL
#define PROBE_DBL 0
#endif
#define REPS(k) ((PROBE_DBL == (k)) ? 2 : 1)
struct Args { const float* in[18]; float* out; unsigned char* ws; };
__global__ void __launch_bounds__(NWAVES * 64, 2) dit_fwd(Args args) {
    extern __shared__ __attribute__((aligned(16))) unsigned char lds[];
    Frame F;
    F.lds = (LAS unsigned char*)lds;
    F.MISC = (volatile LAS unsigned*)(F.lds + MISC_OFF);
    F.wid = __builtin_amdgcn_readfirstlane((int)(threadIdx.x >> 6));
    F.G = gridDim.x; { const int bx = blockIdx.x; F.vcu = (F.G % 8 == 0) ? (bx % 8) * (F.G / 8) + bx / 8 : bx; }
    unsigned char* ws = args.ws;
    F.ctl = (gu32*)(ws + WS_CTL);
    F.out = args.out;
    F.ws = ws;
    for (int u = threadIdx.x; u < (LDS_BYTES - LDSCTL_OFF) / 4; u += NWAVES * 64) ((LAS unsigned*)(F.lds + LDSCTL_OFF))[u] = 0u;
    __syncthreads();
    if (threadIdx.x < 18) { const unsigned long long p = (unsigned long long)(uintptr_t)args.in[threadIdx.x]; ((LAS unsigned*)(F.lds + LDSCTL_OFF))[2 * threadIdx.x] = (unsigned)p; ((LAS unsigned*)(F.lds + LDSCTL_OFF))[2 * threadIdx.x + 1] = (unsigned)(p >> 32); }
    __syncthreads();
    XcdBarrier bar = xcd_barrier_post((unsigned*)(F.ctl + CW_BAR), F.MISC + 8);
#ifdef PROBE_A
#define STAMP(k) do { if (blockIdx.x == 0 && F.wid == 0 && lane_id() == 0) { const unsigned t_ = (unsigned)rt(); F.MISC[16 + (k)] += t_ - F.MISC[15]; F.MISC[15] = t_; } } while (0)
#else
#define STAMP(k) do { } while (0)
#endif
#ifdef PROBE_SKEW
#define ARRIVE(k, i_) do { if ((k) == PROBE_SKEW && F.wid == 0 && lane_id() == 0) { const unsigned t_ = (unsigned)rt(); atomicMax((unsigned*)(F.ctl + 24576 + 4 * (i_)), t_); atomicMax((unsigned*)(F.ctl + 24576 + 4 * (i_) + 1), ~t_); \
    atomicAdd((unsigned*)(F.ctl + 24576 + 4 * (i_) + 2), (t_ & 0xFFFFFu)); atomicMax((unsigned*)(F.ctl + 24576 + 4 * (i_) + 3), ((t_ & 0xFFFFFFu) << 8) | (unsigned)blockIdx.x); } } while (0)
#else
#define ARRIVE(k, i_) do { } while (0)
#endif
#ifdef PROBE_IDLE
#define GRID_BAR() do { XcdBarrier b_ = bar; asm volatile("" : "+s"(b_.x)); xcd_barrier(b_); for (int i_ = 0; i_ < PROBE_IDLE; ++i_) __builtin_amdgcn_s_sleep(127); } while (0)
#elif defined(PROBE_BAR2)
#define GRID_BAR() do { XcdBarrier b_ = bar; asm volatile("" : "+s"(b_.x)); xcd_barrier(b_); xcd_barrier(b_); } while (0)
#else
#define GRID_BAR() do { XcdBarrier b_ = bar; asm volatile("" : "+s"(b_.x)); xcd_barrier(b_); } while (0)
#endif

#ifdef PROBE_A
    if (blockIdx.x == 0 && F.wid == 0 && lane_id() == 0) F.MISC[15] = (unsigned)rt();
#endif
    p0a(F, true); GRID_BAR();
    if (REPS(10) == 2) { p0a(F, false); GRID_BAR(); }
    p0b(F); GRID_BAR(); STAMP(0);

#ifndef BOUSTRO
#define BOUSTRO 0
#endif
    bool dl_up = true;
    for (int f = 0; f < 2 * DEPTH; ++f) {
        const int l = f >> 1, hf = f & 1, kb = hf ? 6 : 0;
        const bool down_f = dl_up; const int g1rev = BOUSTRO ? (down_f ? 0 : 1) : 0, g2rev = BOUSTRO ? (g1rev ? 0 : 1) : 0;
        const bool ctx_ffn = (f < 2 * DEPTH - 1), ctx_mix = (l < DEPTH - 1);

        const int rprev = hf ? 3 * l + 1 : 3 * l - 1;
        for (int rep = 0; rep < REPS(1); ++rep)
        { const float* modl = P_MOD(F) + (size_t)(l * 2) * MODW;
          norm_phase<false>(F, in_ptr(F, I_NORMG) + (size_t)(l * 3 + (hf ? 2 : 0)) * DM, modl, modl + MODW, kb + 0, kb + 1, P_H(F), nullptr, ctx_ffn ? MTOT : SEQ, f <= 1 ? in_ptr(F, I_X) : P_XR(F), f == 0 ? in_ptr(F, I_CTX) : P_XR(F) + (size_t)SEQ * DM, (f == 0 || rep) ? 0 : NSLAB, (f == 0 || rep) ? 0 : ((rprev & 1) + 1), (rprev & 1) != 0, down_f);
        GRID_BAR(); } STAMP(1);
        for (int rep = 0; rep < REPS(2); ++rep)
        { pg8::Gemm g{P_H(F), P_W1(F) + (size_t)f * 2 * DFF * DM, MTOT, 2 * DFF, DM}; pg8::CtxSplitOrder S; S.init(SEQ, 2 * DFF, DM, ctx_ffn ? NSL1 : 0, F.G, (int)blockIdx.x, 0); S.rev = g1rev;
          pg8::EpiSwiGLU E{P_ACT(F), DFF, CTX_PM, P_SLAB1(F)};
          pg8::gemm_phase<pg8::EpiSwiGLU, pg8::CtxSplitOrder, G1_ALIGN, true>(F.lds + RING_OFF, g, S, E, F.wid);
        ARRIVE(2, f); GRID_BAR(); } STAMP(2);
        if (ctx_ffn) { ctx_fix_ffn(F); GRID_BAR(); } STAMP(9);
        for (int rep = 0; rep < REPS(3); ++rep)
        { const float* modl = P_MOD(F) + (size_t)(l * 2) * MODW; const float* modc = modl + MODW;
          pg8::Gemm g{P_ACT(F), P_W2(F) + (size_t)f * DM * DFF, MTOT, DM, DFF}; pg8::CtxSplitOrder S; S.init(SEQ, DM, DFF, ctx_ffn ? NSLAB : 0, F.G, (int)blockIdx.x, MINI_FIRST ? (int)((blockIdx.x & 7) >= 4) : 0); S.rev = g2rev;
          pg8::EpiDelta E{P_DL(F) + (size_t)((hf ? 3 * l + 2 : 3 * l) & 1) * SEQ * DM, DM, modl + (kb + 2) * DM, modc + (kb + 2) * DM, CTX_PM, 0.5f, P_SLAB(F)};
          pg8::gemm_phase<pg8::EpiDelta, pg8::CtxSplitOrder, RESID_ALIGN, true>(F.lds + RING_OFF, g, S, E, F.wid);
        GRID_BAR(); } STAMP(3);
        dl_up = (g2rev == 0);
        if (hf == 0) {
            for (int rep = 0; rep < REPS(1); ++rep)
            { const float* modl = P_MOD(F) + (size_t)(l * 2) * MODW;
              norm_phase<false>(F, in_ptr(F, I_NORMG) + (size_t)(l * 3 + 1) * DM, modl, modl + MODW, 3, 4, P_H(F), nullptr, MTOT, l == 0 ? in_ptr(F, I_X) : P_XR(F), l == 0 ? in_ptr(F, I_CTX) : P_XR(F) + (size_t)SEQ * DM, rep ? 0 : NSLAB, rep ? 0 : (((3 * l) & 1) + 1), ((3 * l) & 1) != 0, dl_up);
            GRID_BAR(); } STAMP(1);
            for (int rep = 0; rep < REPS(4); ++rep)
            { pg8::Gemm g{P_H(F), P_WMI(F) + (size_t)l * INC * DM, MTOT, INC, DM}; pg8::CtxSplitOrder S; S.init(SEQ, INC, DM, NSL2, F.G, (int)blockIdx.x, 0); S.rev = GEMM_REV; S.ord = INPROJ_COLMAJOR;
              pg8::EpiStoreBf16 E{P_PROJ(F), INC, CTX_PM, P_SLAB2(F)};
              pg8::gemm_phase<pg8::EpiStoreBf16, pg8::CtxSplitOrder, true, true>(F.lds + RING_OFF, g, S, E, F.wid);
            GRID_BAR(); } STAMP(4);
            ctx_fix_proj(F); GRID_BAR(); STAMP(10);
            for (int rep = 0; rep < REPS(5); ++rep) {
            for (int nu_ = ((ctx_mix ? MTOT : SEQ) / 128) * 8, u = F.vcu + ((nu_ - 1 - F.vcu) / F.G) * F.G; u >= 0; u -= F.G)
#ifndef NO_SGU
                sgu_unit(F, u >> 3, u & 7, in_ptr(F, I_SGUG) + (size_t)l * 1024, in_ptr(F, I_SGUW) + (size_t)l * 8 * 128 * 128, in_ptr(F, I_SGUB) + (size_t)l * 8 * 128);
#else
                ;
#endif
#ifndef NO_QKN
            if (rep == 0) { const bool fast = attn_noshift_ok(in_ptr(F, I_QKG) + (size_t)l * 256);
                qknorm_rows(F, in_ptr(F, I_QKG) + (size_t)l * 256, fast); }
#endif
            for (int u = F.vcu; u < 512; u += F.G) {
                const bf16* const PROJ = P_PROJ(F); bf16* const CAT = P_CAT(F);
                const int h = u >> 6, blk = u & 63; int lo = 4 * blk - 4; lo = lo < 0 ? 0 : (lo > 244 ? 244 : lo);
                const int wv = F.wid;
                att::NbArgs nb{lo, 4 * blk + (wv >> 1), 32 * (wv & 1) + (lane_id() & 31), in_ptr(F, I_RPB) + (size_t)(l * 8 + h) * 15 * 31, nullptr, nullptr, 0};
#ifndef NO_ATT1
                att::attn_unit<1, INC, INC, DM, ATT1_SDEPTH>(PROJ + (size_t)(blk * 256) * INC + C_QB + h * 128, PROJ + C_KB + h * 128, PROJ + C_VB + h * 128,
                                                CAT + (size_t)(blk * 256) * DM + O_B + h * 128, 0, 16, (char*)lds + RING_OFF, nb, F.wid);
#endif
            }
            GRID_BAR(); } STAMP(5);
            {
            const bool fast = attn_noshift_ok(in_ptr(F, I_QKG) + (size_t)l * 256);
            if (fast)
            for (int u_ = F.vcu; u_ < 1024 * REPS(6); u_ += F.G) { const int u = u_ & 1023;
                const bf16* const PROJ = P_PROJ(F); bf16* const CAT = P_CAT(F);
                const int h = u >> 6, blk = u & 63, kvh = h >> 2;
                att::NbArgs nb{0, 0, 0, nullptr, in_ptr(F, I_QKG) + (size_t)l * 256, P_ROPE(F), blk * 256};
#ifndef NO_ATT0
                att::attn_unit<0, INC, INC, DM, ATT0_SDEPTH>(PROJ + (size_t)(blk * 256) * INC + C_QA + h * 128, PROJ + C_KA + kvh * 128, PROJ + C_VA + kvh * 128,
                                                             CAT + (size_t)(blk * 256) * DM + O_A + h * 128, 0, MTOT / 64, (char*)lds + RING_OFF, nb, F.wid);
#endif
#ifdef A_ROUND_BAR
                if (1024 % F.G == 0 && u_ + F.G < 1024) GRID_BAR();
#endif
            }
            const int nmain2 = fast ? 0 : 1024;
            for (int u = F.vcu; u < nmain2 + (ctx_mix ? 16 + 8 : 0); u += F.G) {
                const bf16* const PROJ = P_PROJ(F); bf16* const CAT = P_CAT(F);
                att::NbArgs nb{0, 0, 0, nullptr, nullptr, nullptr, 0};
                int qrow, qc, kc, vc, oc, kb, nt;
                if (u < nmain2) { const int h = u >> 6, blk = u & 63; qrow = blk * 256; qc = C_QA + h * 128; kc = C_KA + (h >> 2) * 128; vc = C_VA + (h >> 2) * 128; oc = O_A + h * 128; kb = 0; nt = MTOT / 64; }
                else { const int uu = u - nmain2; const bool ga = uu < 16; const int h = ga ? uu : uu - 16; qrow = SEQ; qc = (ga ? C_QA : C_QB) + h * 128; kc = ga ? C_KA + (h >> 2) * 128 : C_KB + h * 128;
                       vc = ga ? C_VA + (h >> 2) * 128 : C_VB + h * 128; oc = (ga ? O_A : O_B) + h * 128; kb = SEQ; nt = CTXL / 64; }
                att::attn_unit<2, INC, INC, DM, 1>(PROJ + (size_t)qrow * INC + qc, PROJ + kc, PROJ + vc, CAT + (size_t)qrow * DM + oc, kb, nt, (char*)lds + RING_OFF, nb, F.wid);
            }
            ARRIVE(6, l); GRID_BAR(); } STAMP(6);
            for (int rep = 0; rep < REPS(7); ++rep)
            { const float* modl = P_MOD(F) + (size_t)(l * 2) * MODW; const float* modc = modl + MODW;
              pg8::Gemm g{P_CAT(F), P_WMO(F) + (size_t)l * DM * DM, MTOT, DM, DM}; pg8::CtxSplitOrder S; S.init(SEQ, DM, DM, ctx_mix ? NSLAB : 0, F.G, (int)blockIdx.x, MINI_FIRST ? (int)((blockIdx.x & 7) >= 4) : 0);
              pg8::EpiDelta E{P_DL(F) + (size_t)((3 * l + 1) & 1) * SEQ * DM, DM, modl + 5 * DM, modc + 5 * DM, CTX_PM, 1.0f, P_SLAB(F)};
              pg8::gemm_phase<pg8::EpiDelta, pg8::CtxSplitOrder, RESID_ALIGN, true>(F.lds + RING_OFF, g, S, E, F.wid);
            GRID_BAR(); } STAMP(7);
            dl_up = true;
        }
    }
    norm_phase<true>(F, in_ptr(F, I_FING), nullptr, nullptr, 0, 0, nullptr, F.out, SEQ, P_XR(F), P_XR(F), 0, 2, false, dl_up);
    if (__hip_atomic_load((gu32*)((unsigned*)(F.ctl + CW_BAR) + XB_TMO), RLX_AGENT) != 0u) {
        int tl_ = threadIdx.x; asm volatile("" : "+v"(tl_));
        const int gw = F.vcu * NWAVES + F.wid, NGW = F.G * NWAVES; const float qn = __builtin_nanf("");
        for (int m = gw; m < SEQ; m += NGW) { GAS f32x4* o = (GAS f32x4*)(F.out + (size_t)m * DM) + (tl_ & 63);
#pragma unroll
            for (int j = 0; j < 16; ++j) o[64 * j] = (f32x4){qn, qn, qn, qn}; }
    }
#ifdef PROBE_A
    GRID_BAR(); STAMP(8);
    if (blockIdx.x == 0 && F.wid == 0) { const unsigned span = F.MISC[16 + PROBE_A] * (unsigned)PROBE_MUL; const unsigned t0 = (unsigned)rt(); while ((unsigned)rt() - t0 < span) __builtin_amdgcn_s_sleep(100); }
#endif
#ifdef PROBE_SKEW
    GRID_BAR();
    if (blockIdx.x == 0 && F.wid == 0) { unsigned span = 0; for (int i = 0; i < 8; ++i) { const unsigned a = __hip_atomic_load((gu32*)(F.ctl + 24576 + 4 * i), RLX_AGENT), b = ~__hip_atomic_load((gu32*)(F.ctl + 24576 + 4 * i + 1), RLX_AGENT);
            const unsigned sm = __hip_atomic_load((gu32*)(F.ctl + 24576 + 4 * i + 2), RLX_AGENT), who = __hip_atomic_load((gu32*)(F.ctl + 24576 + 4 * i + 3), RLX_AGENT) & 255u;
            if (a != 0u) {
                if (PROBE_WHAT == 0) span += (a - b) * (unsigned)PROBE_MUL;
                else if (PROBE_WHAT == 1) { const unsigned base = b & ~0xFFFFFu; const unsigned mean = (unsigned)(((unsigned long long)sm + ((b & 0xFFFFFu) > (a & 0xFFFFFu) ? 0u : 0u)) / (unsigned)F.G); span += ((a & 0xFFFFFu) - mean) * (unsigned)PROBE_MUL; (void)base; }
                else if (i == PROBE_WHICH) span += (PROBE_WHAT == 2 ? (who & 7u) * 50000u + (who >> 3) * 1000u : 0u);
            } }
        const unsigned t0 = (unsigned)rt(); while ((unsigned)rt() - t0 < span) __builtin_amdgcn_s_sleep(100); }
#endif
}

extern "C" void kernel_launch(void* const* d_in, const int* in_sizes, int n_in, void* d_out, int out_size, void* d_ws, size_t ws_size, hipStream_t stream) {
    static int grid = 0;
    if (grid == 0) {
        if (n_in != 18 || in_sizes[0] != SEQ * DM || out_size != SEQ * DM || ws_size < WS_END) {
            fprintf(stderr, "kernel_launch: built for 18 inputs, x/out of %d floats, >= %zu bytes of workspace; got n_in %d, in0 %d, out %d, ws %zu; nothing launched\n", SEQ * DM, (size_t)WS_END, n_in, n_in > 0 ? in_sizes[0] : -1, out_size, ws_size);
            grid = -1; return; }
        int dev = 0, cus = 0, per_cu = 0;
        if (hipGetDevice(&dev) != hipSuccess || hipDeviceGetAttribute(&cus, hipDeviceAttributeMultiprocessorCount, dev) != hipSuccess) { fprintf(stderr, "kernel_launch: device query failed\n"); grid = -1; return; }
        if (hipFuncSetAttribute((const void*)dit_fwd, hipFuncAttributeMaxDynamicSharedMemorySize, LDS_BYTES) != hipSuccess) { fprintf(stderr, "kernel_launch: hipFuncSetAttribute failed\n"); grid = -1; return; }
        if (hipOccupancyMaxActiveBlocksPerMultiprocessor(&per_cu, (const void*)dit_fwd, NWAVES * 64, LDS_BYTES) != hipSuccess || per_cu < 1)
            fprintf(stderr, "kernel_launch: note: occupancy query reports %d workgroups per CU\n", per_cu);
        (void)hipGetLastError();
        grid = cus;
    }
    if (grid < 0) return;
    if (hipMemsetAsync((char*)d_ws + WS_CTL, 0, CTL_ZERO_BYTES, stream) != hipSuccess) { fprintf(stderr, "kernel_launch: hipMemsetAsync failed\n"); return; }
    Args a{};
    for (int i = 0; i < 18; ++i) a.in[i] = (const float*)d_in[i];
    a.out = (float*)d_out; a.ws = (unsigned char*)d_ws;
    hipLaunchKernelGGL(dit_fwd, dim3(grid), dim3(NWAVES * 64), LDS_BYTES, stream, a);
    const hipError_t le = hipPeekAtLastError();
    if (le != hipSuccess) fprintf(stderr, "kernel_launch: launch failed: %s\n", hipGetErrorName(le));
}
```

```cpp
#include <hip/hip_runtime.h>
#include <cstdio>
#include <cstdint>
namespace pg8 {
#define PG8_LAS __attribute__((address_space(3)))
typedef unsigned short bf16_t;
typedef short bf16x8 __attribute__((ext_vector_type(8)));
typedef float f32x4 __attribute__((ext_vector_type(4)));
typedef unsigned u32x4 __attribute__((ext_vector_type(4)));
constexpr int BM = 256, BK = 64, HALF = 128, HTB = HALF * BK * 2  , STAGE_BYTES = 8 * HTB, NXCD = 8, WGM = 8;

__host__ __device__ __forceinline__ int lds_byte(int r, int c) { const int st = (r >> 4) * 2 + (c >> 5), rr = r & 15, cc = c & 31, ob = rr * 64 + cc * 2; return st * 1024 + (ob ^ (((ob >> 9) & 1) << 5)); }
__host__ __device__ __forceinline__ void stage_rc(int b, int& R, int& C) { const int st = b / 1024, sb = b % 1024, swz = sb ^ (((sb >> 9) & 1) << 5); R = (st >> 1) * 16 + swz / 64; C = (st & 1) * 32 + (swz % 64) / 2; }
__host__ __device__ __forceinline__ int perm32(int rho) { const int n = rho >> 4, i = rho & 15; return 8 * (i >> 2) + 4 * n + (i & 3); }

struct Unit { int pm, pn, kt0, nt; };
struct Gemm { const bf16_t* A; const bf16_t* Bt; int M, N, K; };

struct StaticOrder {
    int nM, nN, nwg, G, c, ntf;
    __host__ __device__ __forceinline__ void init(int M, int N, int K, int G_, int c_) { nM = M / BM; nN = N / BM; nwg = nM * nN; G = G_; c = c_; ntf = K / BK; }
    __host__ __device__ __forceinline__ bool next(int i, Unit& u) const {
        const long L = (long)i * G + c; if (L >= nwg) return false;
        int wgid = (int)L; { const int q = nwg / NXCD, r = nwg % NXCD, xcd = wgid % NXCD, off = wgid / NXCD; wgid = (xcd < r ? xcd * (q + 1) : r * (q + 1) + (xcd - r) * q) + off; }
        const int nig = WGM * nN, gid = wgid / nig, fm = gid * WGM, gsz = (nM - fm) < WGM ? (nM - fm) : WGM;
        u.pm = fm + ((wgid % nig) % gsz); u.pn = (wgid % nig) / gsz; u.kt0 = 0; u.nt = ntf; return true;
    }
    __device__ __forceinline__ void a_ready(const Unit&) const {}
    __device__ __forceinline__ void done(const Unit&) const {}
};
struct CtxSplitOrder : StaticOrder {
    int S, first, rev, ord;
    __host__ __device__ __forceinline__ void init(int Mlat, int N, int K, int S_, int G_, int c_, int first_) { StaticOrder::init(Mlat, N, K, G_, c_); S = S_; first = (S_ > 0) ? first_ : 0; rev = 0; ord = 0; }
    __host__ __device__ __forceinline__ bool next(int i, Unit& u) const {
        const int nmini = nN * S, rl = c < nwg ? (nwg - c + G - 1) / G : 0, rm = c < nmini ? (nmini - c + G - 1) / G : 0;
        const bool mini = first ? (i < rm) : (i >= rl); const int ii = first ? (mini ? i : i - rm) : (mini ? i - rl : i);
        const long L = (long)ii * G + c; const bool lat = !mini;
        int wgid = (lat && L < nwg) ? (int)L : 0; { const int q = nwg / NXCD, r = nwg % NXCD, xcd = wgid % NXCD, off = wgid / NXCD; wgid = (xcd < r ? xcd * (q + 1) : r * (q + 1) + (xcd - r) * q) + off; }
        const int nig = WGM * nN, gid = wgid / nig, fm = gid * WGM, gsz = (nM - fm) < WGM ? (nM - fm) : WGM;
#ifndef SQ_ROUND
#define SQ_ROUND 1
#endif
        const bool sq = SQ_ROUND && G == 256 && (nM & 15) == 0 && (nN & 15) == 0;
#ifndef SQ_ORDER
#define SQ_ORDER 0
#endif
        const int nsn = nN >> 4, nsm = nM >> 4, ri = lat ? i : 0, sm = (SQ_ORDER || ord) ? ri % (nsm > 0 ? nsm : 1) : ri / (nsn > 0 ? nsn : 1), sn = (SQ_ORDER || ord) ? ri / (nsm > 0 ? nsm : 1) : ri % (nsn > 0 ? nsn : 1), xq = c & 7, sl = c >> 3;
#ifndef SQ_SNAKE
#define SQ_SNAKE 0
#endif
        const int smr = rev ? (nsm - 1 - sm) : sm, snr = (SQ_SNAKE && !(SQ_ORDER || ord) && (sm & 1)) ? (nsn - 1 - sn) : sn;
        const int pm_q = SQ_ROUND == 2 ? 16 * smr + 4 * (xq >> 1) + (sl & 3) : 16 * smr + 8 * (xq >> 2) + (sl & 7), pn_q = SQ_ROUND == 2 ? 16 * snr + 8 * (xq & 1) + (sl >> 2) : 16 * snr + 4 * (xq & 3) + (sl >> 3);
        const int pm_l = sq ? pm_q : fm + ((wgid % nig) % gsz), pn_l = sq ? pn_q : (wgid % nig) / gsz;
        const int j = lat ? 0 : (int)L, Sd = S > 0 ? S : 1, ntm = ntf / Sd;
        u.pm = lat ? pm_l : nM; u.pn = lat ? pn_l : j / Sd; u.nt = lat ? ntf : ntm; u.kt0 = lat ? 0 : (j % Sd) * ntm;
        return lat ? (L < nwg) : (L < nmini);
    }
};

__device__ __forceinline__ unsigned cvt_pk_bf16(float lo, float hi) { unsigned r; asm volatile("v_cvt_pk_bf16_f32 %0, %1, %2" : "=v"(r) : "v"(lo), "v"(hi)); return r; }
typedef float f32x2 __attribute__((ext_vector_type(2)));
__device__ __forceinline__ f32x2 gelu_pk(f32x2 v) {
    const f32x2 av = __builtin_elementwise_abs(v), d = av * 0.2316418882f + 1.0f;
    f32x2 t; t.x = __builtin_amdgcn_rcpf(d.x); t.y = __builtin_amdgcn_rcpf(d.y);
    f32x2 q = t * 0.5307027145f + (-0.7265760135f); q = q * t + 0.7107068705f; q = q * t + (-0.142248368f); q = q * t + 0.127414796f; q = q * t;
    const f32x2 s = (v * v) * (-0.72134752044f);
    f32x2 e; e.x = __builtin_amdgcn_exp2f(s.x); e.y = __builtin_amdgcn_exp2f(s.y);
    const f32x2 m = v * (q * e), r = v - m;
    f32x2 o; o.x = v.x < 0.f ? m.x : r.x; o.y = v.y < 0.f ? m.y : r.y; return o;
}

template <int ACT  > struct EpiBf16 {
    static constexpr bool PERM = true, AFTER_DRAIN = false; static constexpr int OPND_AUX = 0; static_assert(ACT == 0 || ACT == 1, "EpiBf16: ACT is 0 (none) or 1 (gelu_pk)");
    bf16_t* O; int ldc; const float* bias; int split_cols; size_t split_stride; float scale0;
    __device__ __forceinline__ void operator()(const f32x4 (&acc)[2][2][4][2], const Unit& u, int wr, int wc, int fr, int fq) const {
        const int row0 = u.pm * BM + wr * 64 + fr; int colt = u.pn * BM; bf16_t* base = O;
        float sc = 1.f; if (split_cols) { const int t = colt / split_cols; base += (size_t)t * split_stride; colt -= t * split_cols; if (t == 0) sc = scale0; }
        const int col0 = colt + wc * 32 + 8 * fq, bcol0 = u.pn * BM + wc * 32 + 8 * fq;
        f32x4 bv[2][2];
#pragma unroll
        for (int bj = 0; bj < 2; ++bj)
#pragma unroll
            for (int n = 0; n < 2; ++n) bv[bj][n] = bias ? *(const f32x4*)(bias + bcol0 + bj * HALF + 4 * n) : (f32x4){0.f, 0.f, 0.f, 0.f};
#pragma unroll
        for (int ai = 0; ai < 2; ++ai)
#pragma unroll
            for (int m = 0; m < 4; ++m) { bf16_t* rowp = base + (size_t)(row0 + ai * HALF + m * 16) * ldc + col0;
#pragma unroll
                for (int bj = 0; bj < 2; ++bj) { f32x4 v0 = acc[ai][bj][m][0] + bv[bj][0], v1 = acc[ai][bj][m][1] + bv[bj][1];
                    if (ACT == 1) { f32x2 a = gelu_pk((f32x2){v0[0], v0[1]}), b = gelu_pk((f32x2){v0[2], v0[3]}), c = gelu_pk((f32x2){v1[0], v1[1]}), d = gelu_pk((f32x2){v1[2], v1[3]});
                        v0 = (f32x4){a.x, a.y, b.x, b.y}; v1 = (f32x4){c.x, c.y, d.x, d.y}; }
                    v0 = v0 * sc; v1 = v1 * sc; u32x4 w; w.x = cvt_pk_bf16(v0[0], v0[1]); w.y = cvt_pk_bf16(v0[2], v0[3]); w.z = cvt_pk_bf16(v1[0], v1[1]); w.w = cvt_pk_bf16(v1[2], v1[3]);
                    *(u32x4*)(rowp + bj * HALF) = w; } }
    }
};

struct EpiSwiGLU {
    static constexpr bool PERM = true, AFTER_DRAIN = false; static constexpr int OPND_AUX = 0;
    bf16_t* O; int ldc; int ctx_pm; bf16_t* slab;
    __device__ __forceinline__ void operator()(const f32x4 (&acc)[2][2][4][2], const Unit& u, int wr, int wc, int fr, int fq) const {
        const bool part = (u.pm >= ctx_pm);
        const int row0 = (part ? 0 : u.pm * BM) + wr * 64 + fr, col0 = u.pn * (part ? BM : HALF) + wc * 32 + 8 * fq, pitch = part ? 2 * ldc : ldc;
        bf16_t* base = part ? slab + (size_t)(u.kt0 / u.nt) * BM * (2 * ldc) : O;
#pragma unroll
        for (int ai = 0; ai < 2; ++ai)
#pragma unroll
            for (int m = 0; m < 4; ++m) {
                bf16_t* rowp = base + (size_t)(row0 + ai * HALF + m * 16) * pitch + col0;
                float r[8];
#pragma unroll
                for (int n = 0; n < 2; ++n)
#pragma unroll
                    for (int e = 0; e < 4; ++e) { const float a = acc[ai][0][m][n][e], b = acc[ai][1][m][n][e];
                        const float s = __builtin_amdgcn_rcpf(1.f + __builtin_amdgcn_exp2f(a * -1.4426950408889634f)); r[n * 4 + e] = part ? a : (a * s) * b; }
                u32x4 w; w.x = cvt_pk_bf16(r[0], r[1]); w.y = cvt_pk_bf16(r[2], r[3]); w.z = cvt_pk_bf16(r[4], r[5]); w.w = cvt_pk_bf16(r[6], r[7]);
#ifndef ACT_NT
#define ACT_NT 0
#endif
                if (ACT_NT) __builtin_nontemporal_store(w, (u32x4*)rowp); else *(u32x4*)rowp = w;
                if (part) { u32x4 wb; wb.x = cvt_pk_bf16(acc[ai][1][m][0][0], acc[ai][1][m][0][1]); wb.y = cvt_pk_bf16(acc[ai][1][m][0][2], acc[ai][1][m][0][3]);
                    wb.z = cvt_pk_bf16(acc[ai][1][m][1][0], acc[ai][1][m][1][1]); wb.w = cvt_pk_bf16(acc[ai][1][m][1][2], acc[ai][1][m][1][3]); *(u32x4*)(rowp + HALF) = wb; } }
    }
};
struct EpiStoreBf16 {
    static constexpr bool PERM = true, AFTER_DRAIN = false; static constexpr int OPND_AUX = 0;
    bf16_t* O; int ldc; int ctx_pm; bf16_t* slab;
    __device__ __forceinline__ void operator()(const f32x4 (&acc)[2][2][4][2], const Unit& u, int wr, int wc, int fr, int fq) const {
        const bool part = (u.pm >= ctx_pm);
        const int row0 = (part ? 0 : u.pm * BM) + wr * 64 + fr, col0 = u.pn * BM + wc * 32 + 8 * fq;
        bf16_t* base = part ? slab + (size_t)(u.kt0 / u.nt) * BM * ldc : O;
#pragma unroll
        for (int ai = 0; ai < 2; ++ai)
#pragma unroll
            for (int m = 0; m < 4; ++m) { bf16_t* rowp = base + (size_t)(row0 + ai * HALF + m * 16) * ldc + col0;
#pragma unroll
                for (int bj = 0; bj < 2; ++bj) { const f32x4 v0 = acc[ai][bj][m][0], v1 = acc[ai][bj][m][1];
                    u32x4 w; w.x = cvt_pk_bf16(v0[0], v0[1]); w.y = cvt_pk_bf16(v0[2], v0[3]); w.z = cvt_pk_bf16(v1[0], v1[1]); w.w = cvt_pk_bf16(v1[2], v1[3]);
                    *(u32x4*)(rowp + bj * HALF) = w; } }
    }
};
#ifndef RESID_OPND_AUX
#define RESID_OPND_AUX 0
#endif
struct EpiDelta {
    static constexpr bool PERM = true, AFTER_DRAIN = false; static constexpr int OPND_AUX = RESID_OPND_AUX;
    bf16_t* Dl; int ldc; const float* gate; const float* gate_c; int ctx_pm; float gs; bf16_t* slab;
    __device__ __forceinline__ void operator()(const f32x4 (&acc)[2][2][4][2], const Unit& u, int wr, int wc, int fr, int fq) const {
        const bool part = (u.pm >= ctx_pm);
        const int row0 = (part ? 0 : u.pm * BM) + wr * 64 + fr, col0 = u.pn * BM + wc * 32 + 8 * fq;
        const float* gp = part ? gate_c : gate;
        bf16_t* base = part ? slab + (size_t)(u.kt0 / u.nt) * BM * ldc : Dl;
        f32x4 gv[2][2];
#pragma unroll
        for (int bj = 0; bj < 2; ++bj)
#pragma unroll
            for (int n = 0; n < 2; ++n) gv[bj][n] = *(const f32x4*)(gp + col0 + bj * HALF + 4 * n) * gs;
#pragma unroll
        for (int ai = 0; ai < 2; ++ai)
#pragma unroll
            for (int m = 0; m < 4; ++m) { bf16_t* rowp = base + (size_t)(row0 + ai * HALF + m * 16) * ldc + col0;
#pragma unroll
                for (int bj = 0; bj < 2; ++bj) { const f32x4 v0 = gv[bj][0] * acc[ai][bj][m][0], v1 = gv[bj][1] * acc[ai][bj][m][1];
                    u32x4 w; w.x = cvt_pk_bf16(v0[0], v0[1]); w.y = cvt_pk_bf16(v0[2], v0[3]); w.z = cvt_pk_bf16(v1[0], v1[1]); w.w = cvt_pk_bf16(v1[2], v1[3]);
                    *(u32x4*)(rowp + bj * HALF) = w; } }
    }
};

template <class Epi, class Sched, bool ALIGN_EPI = false, bool SP2 = false>
__device__ __forceinline__ void gemm_phase(PG8_LAS unsigned char* lds, const Gemm g, const Sched& S, const Epi& E, int wid_in  ) {
    int tid_ = threadIdx.x; (void)wid_in; asm volatile("" : "+v"(tid_));
    const int tid = tid_, wid = __builtin_amdgcn_readfirstlane(tid >> 6), lane = tid & 63, wr = wid >> 2, wc = wid & 3, fr = lane & 15, fq = lane >> 4;
    const int K = g.K;
    unsigned voffA[2], voffB[2];
#pragma unroll
    for (int i = 0; i < 2; ++i) { int R, C; stage_rc(tid * 16 + i * 8192, R, C); const int Rb = Epi::PERM ? ((R & ~31) + perm32(R & 31)) : R;
        voffA[i] = (unsigned)(R * K + C) * 2u; voffB[i] = (unsigned)(Rb * K + C) * 2u; }
    const size_t kstep = (size_t)(BK * 2);
    const size_t hstep = (size_t)HALF * K * 2;
    const size_t tstep = 2 * hstep;
    const unsigned ldsw = (unsigned)wid * 1024u;
    const int aoff = lds_byte(wr * 64 + fr, fq * 8), boff = lds_byte(wc * 32 + fr, fq * 8);
#define PG8_SA(b, h) (((b) * 2 + (h)) * HTB)
#define PG8_SB(b, h) ((4 + (b) * 2 + (h)) * HTB)
#define PG8_STAGE(bufoff, gbase, voff) do { _Pragma("unroll") for (int _i = 0; _i < 2; ++_i) \
        __builtin_amdgcn_global_load_lds((const unsigned*)((const char*)(gbase) + (voff)[_i]), (PG8_LAS unsigned*)(lds + (bufoff) + ldsw + _i * 8192), 16, 0, Epi::OPND_AUX); } while (0)
#define PG8_LDA(dst, b, h) do { _Pragma("unroll") for (int m = 0; m < 4; ++m) _Pragma("unroll") for (int k = 0; k < 2; ++k) dst[m][k] = *(const PG8_LAS bf16x8*)(lds + PG8_SA(b, h) + aoff + m * 2048 + k * 1024); } while (0)
#define PG8_LDB(dst, b, h) do { _Pragma("unroll") for (int n = 0; n < 2; ++n) _Pragma("unroll") for (int k = 0; k < 2; ++k) dst[n][k] = *(const PG8_LAS bf16x8*)(lds + PG8_SB(b, h) + boff + n * 2048 + k * 1024); } while (0)
#define PG8_MMA(ai, bj, At, Bt) do { __builtin_amdgcn_s_setprio(1); _Pragma("unroll") for (int m = 0; m < 4; ++m) _Pragma("unroll") for (int n = 0; n < 2; ++n) _Pragma("unroll") for (int k = 0; k < 2; ++k) \
        acc[ai][bj][m][n] = __builtin_amdgcn_mfma_f32_16x16x32_bf16(Bt[n][k], At[m][k], acc[ai][bj][m][n], 0, 0, 0); __builtin_amdgcn_s_setprio(0); } while (0)
#define PG8_WAIT_V(n) asm volatile("s_waitcnt vmcnt(" #n ")" ::: "memory")
#define PG8_WAIT_L(n) asm volatile("s_waitcnt lgkmcnt(" #n ")" ::: "memory")
#define PG8_BAR __builtin_amdgcn_s_barrier()
#define PG8_SCHED __builtin_amdgcn_sched_barrier(0)
    Unit cur, nxt; int ui = 0;
    if (!S.next(0, cur)) return;
    f32x4 acc[2][2][4][2];
#pragma unroll
    for (int a = 0; a < 2; ++a)
#pragma unroll
        for (int b = 0; b < 2; ++b)
#pragma unroll
            for (int m = 0; m < 4; ++m)
#pragma unroll
                for (int n = 0; n < 2; ++n) acc[a][b][m][n] = (f32x4){0.f, 0.f, 0.f, 0.f};
    bf16x8 At[4][2], B0[2][2], B1[2][2];
    const char* cA = (const char*)g.A + (size_t)cur.pm * tstep + (size_t)cur.kt0 * kstep; const char* cB = (const char*)g.Bt + (size_t)cur.pn * tstep + (size_t)cur.kt0 * kstep;
    S.a_ready(cur);
    if constexpr (SP2) {
        PG8_STAGE(PG8_SB(0, 0), cB, voffB); PG8_STAGE(PG8_SB(0, 1), cB + hstep, voffB); PG8_STAGE(PG8_SA(0, 0), cA, voffA); PG8_STAGE(PG8_SA(0, 1), cA + hstep, voffA);
        if (wr == 1) PG8_BAR;
        PG8_WAIT_V(2); PG8_BAR;
        PG8_STAGE(PG8_SB(1, 0), cB + kstep, voffB); PG8_STAGE(PG8_SA(1, 0), cA + kstep, voffA); PG8_STAGE(PG8_SB(1, 1), cB + hstep + kstep, voffB);
        PG8_WAIT_V(6); PG8_BAR;
    } else {
        PG8_STAGE(PG8_SB(0, 0), cB, voffB); PG8_STAGE(PG8_SA(0, 0), cA, voffA); PG8_STAGE(PG8_SB(0, 1), cB + hstep, voffB); PG8_STAGE(PG8_SA(0, 1), cA + hstep, voffA);
        if (wr == 1) PG8_BAR;
        PG8_WAIT_V(4); PG8_BAR;
        PG8_STAGE(PG8_SB(1, 0), cB + kstep, voffB); PG8_STAGE(PG8_SA(1, 0), cA + kstep, voffA); PG8_STAGE(PG8_SB(1, 1), cB + hstep + kstep, voffB);
        PG8_WAIT_V(6); PG8_BAR;
    }
    for (;;) {
        const bool has_next = S.next(ui + 1, nxt);
        const char* nA = has_next ? (const char*)g.A + (size_t)nxt.pm * tstep + (size_t)nxt.kt0 * kstep : cA; const char* nB = has_next ? (const char*)g.Bt + (size_t)nxt.pn * tstep + (size_t)nxt.kt0 * kstep : cB;
        const int nt = cur.nt;
        for (int t = 0; t < nt; t += 2) {
            const bool last = (t == nt - 2);
            const char* a1 = cA + (size_t)(t + 1) * kstep;
            const char* a2 = last ? nA : cA + (size_t)(t + 2) * kstep; const char* b2 = last ? nB : cB + (size_t)(t + 2) * kstep;
            const char* a3 = a2 + kstep; const char* b3 = b2 + kstep;
            if (last && has_next) S.a_ready(nxt);
            if constexpr (SP2) {
            PG8_LDB(B0, 0, 0); PG8_LDB(B1, 0, 1); PG8_SCHED; PG8_LDA(At, 0, 0); PG8_STAGE(PG8_SA(1, 1), a1 + hstep, voffA);
            PG8_WAIT_V(8); PG8_WAIT_L(0); PG8_BAR; PG8_MMA(0, 0, At, B0); PG8_MMA(0, 1, At, B1); PG8_BAR; PG8_SCHED;
            PG8_LDA(At, 0, 1); PG8_STAGE(PG8_SB(0, 0), b2, voffB); PG8_STAGE(PG8_SB(0, 1), b2 + hstep, voffB); PG8_STAGE(PG8_SA(0, 0), a2, voffA);
            PG8_WAIT_V(8); PG8_WAIT_L(0); PG8_BAR; PG8_MMA(1, 0, At, B0); PG8_MMA(1, 1, At, B1); PG8_BAR; PG8_SCHED;
            PG8_LDB(B0, 1, 0); PG8_LDB(B1, 1, 1); PG8_SCHED; PG8_LDA(At, 1, 0); PG8_STAGE(PG8_SA(0, 1), a2 + hstep, voffA);
            PG8_WAIT_V(8); PG8_WAIT_L(0); PG8_BAR; PG8_MMA(0, 0, At, B0); PG8_MMA(0, 1, At, B1); PG8_BAR; PG8_SCHED;
            PG8_LDA(At, 1, 1); PG8_STAGE(PG8_SB(1, 0), b3, voffB); PG8_STAGE(PG8_SB(1, 1), b3 + hstep, voffB); PG8_STAGE(PG8_SA(1, 0), a3, voffA);
            PG8_WAIT_V(8); PG8_WAIT_L(0); PG8_BAR; PG8_MMA(1, 0, At, B0); PG8_MMA(1, 1, At, B1); PG8_BAR; PG8_SCHED;
            } else {
            PG8_LDB(B0, 0, 0); PG8_SCHED; PG8_LDA(At, 0, 0); PG8_STAGE(PG8_SA(1, 1), a1 + hstep, voffA);
            PG8_WAIT_L(8); PG8_BAR; PG8_WAIT_L(0); PG8_MMA(0, 0, At, B0); PG8_BAR; PG8_SCHED;
            PG8_LDB(B1, 0, 1); PG8_STAGE(PG8_SB(0, 0), b2, voffB);
            PG8_BAR; PG8_WAIT_L(0); PG8_MMA(0, 1, At, B1); PG8_BAR;
            PG8_LDA(At, 0, 1); PG8_STAGE(PG8_SA(0, 0), a2, voffA);
            PG8_BAR; PG8_WAIT_L(0); PG8_MMA(1, 0, At, B0); PG8_BAR; PG8_SCHED;
            PG8_STAGE(PG8_SB(0, 1), b2 + hstep, voffB);
            PG8_WAIT_V(6); PG8_BAR; PG8_MMA(1, 1, At, B1); PG8_BAR;
            PG8_LDB(B0, 1, 0); PG8_SCHED; PG8_LDA(At, 1, 0); PG8_STAGE(PG8_SA(0, 1), a2 + hstep, voffA);
            PG8_WAIT_L(8); PG8_BAR; PG8_WAIT_L(0); PG8_MMA(0, 0, At, B0); PG8_BAR; PG8_SCHED;
            PG8_LDB(B1, 1, 1); PG8_STAGE(PG8_SB(1, 0), b3, voffB);
            PG8_BAR; PG8_WAIT_L(0); PG8_MMA(0, 1, At, B1); PG8_BAR;
            PG8_LDA(At, 1, 1); PG8_STAGE(PG8_SA(1, 0), a3, voffA);
            PG8_BAR; PG8_WAIT_L(0); PG8_MMA(1, 0, At, B0); PG8_BAR; PG8_SCHED;
            PG8_STAGE(PG8_SB(1, 1), b3 + hstep, voffB);
            PG8_WAIT_V(6); PG8_BAR; PG8_MMA(1, 1, At, B1); PG8_BAR;
            }
        }
        if constexpr (ALIGN_EPI) { if (wr == 0) PG8_BAR; }
        if constexpr (!Epi::AFTER_DRAIN) { E(acc, cur, wr, wc, fr, fq); S.done(cur); }
        if (!has_next) break;
#pragma unroll
        for (int a = 0; a < 2; ++a)
#pragma unroll
            for (int b = 0; b < 2; ++b)
#pragma unroll
                for (int m = 0; m < 4; ++m)
#pragma unroll
                    for (int n = 0; n < 2; ++n) acc[a][b][m][n] = (f32x4){0.f, 0.f, 0.f, 0.f};
        cur = nxt; cA = nA; cB = nB; ++ui;
        if constexpr (ALIGN_EPI) { if (wr == 1) PG8_BAR; }
    }
    PG8_WAIT_V(0);
    if constexpr (!ALIGN_EPI) { if (wr == 0) PG8_BAR; }
    PG8_BAR;
    if constexpr (Epi::AFTER_DRAIN) { E.fused(acc, cur, wr, wc, fr, fq, lds, wid, lane); S.done(cur); }
#undef PG8_SA
#undef PG8_SB
#undef PG8_STAGE
#undef PG8_LDA
#undef PG8_LDB
#undef PG8_MMA
#undef PG8_WAIT_V
#undef PG8_WAIT_L
#undef PG8_BAR
#undef PG8_SCHED
}
}

namespace att {
typedef unsigned short bf16;
using bf16x8 = __attribute__((ext_vector_type(8))) short;
using s16x4  = __attribute__((ext_vector_type(4))) short;
using f32x16 = __attribute__((ext_vector_type(16))) float;
using u32x4  = __attribute__((ext_vector_type(4))) unsigned;
constexpr int   D = 128, NW = 8, QBLK = 32, KVBLK = 64;
constexpr float SCALE = 0.088388347648318440f;
constexpr float THR = 8.f;
#ifndef ATT0_RING3
#define ATT0_RING3 1
#endif
#ifndef ATT0_LEADBAR
#define ATT0_LEADBAR SBAR()
#endif
#ifndef ATT0_INBAR
#define ATT0_INBAR SBAR()
#endif
#ifndef ATT0_MIDBAR
#define ATT0_MIDBAR (void)0
#endif
#ifndef ATT0_PRIO
#define ATT0_PRIO 1
#endif
#define ATT0_NT 260
constexpr size_t SHM_V = KVBLK * D * 2, SHM_K = KVBLK * D * 2, SHM_ATTN = 2 * SHM_V + 2 * SHM_K + NW * 64 * 4;
constexpr int NRING = 4, WS_OFF = 131072 + 1024, RPB_OFF = WS_OFF + NW * 64 * 4;
constexpr int NB_WIN_TILES = 12, SEQ_LAT = 16384;
#define KSWZ(row, colB) ((row) * 256 + ((colB) ^ (((row) & 7) << 4)))
#define SBAR() __builtin_amdgcn_sched_barrier(0)
__device__ __forceinline__ int crow(int r, int hi) { return (r & 3) + 8 * (r >> 2) + 4 * hi; }
__device__ __forceinline__ unsigned cvtpk(float lo, float hi) {
  unsigned r; asm volatile("v_cvt_pk_bf16_f32 %0, %1, %2" : "=v"(r) : "v"(lo), "v"(hi)); return r;
}
__device__ __forceinline__ void partialSM(f32x16& p0, f32x16& p1, float& m_reg, float& mn, float& alpha) {
  constexpr float C = SCALE * 1.4426950408889634f;
  float pmax = p0[0];
#pragma unroll
  for (int r = 1; r < 16; ++r) pmax = fmaxf(pmax, p0[r]);
#pragma unroll
  for (int r = 0; r < 16; ++r) pmax = fmaxf(pmax, p1[r]);
  { auto rr = __builtin_amdgcn_permlane32_swap(__float_as_uint(pmax), __float_as_uint(pmax), false, false);
    pmax = fmaxf(__uint_as_float(rr[0]), __uint_as_float(rr[1])); }
  if (__builtin_expect(__all(pmax - m_reg <= THR / SCALE), 1)) { mn = m_reg; alpha = 1.f; }
  else { mn = fmaxf(m_reg, pmax); alpha = __builtin_amdgcn_exp2f((m_reg - mn) * C); m_reg = mn; }
  float mnC = -mn * C;
#pragma unroll
  for (int r = 0; r < 16; ++r) p0[r] = fmaf(p0[r], C, mnC);
#pragma unroll
  for (int r = 0; r < 16; ++r) p1[r] = fmaf(p1[r], C, mnC);
#pragma unroll
  for (int r = 0; r < 16; ++r) p0[r] = __builtin_amdgcn_exp2f(p0[r]);
}
__device__ __forceinline__ void finishSM(f32x16& p0, f32x16& p1, float alpha, float& l_reg, bf16x8& pa0, bf16x8& pa1, bf16x8& pa2, bf16x8& pa3) {
#pragma unroll
  for (int r = 0; r < 16; ++r) p1[r] = __builtin_amdgcn_exp2f(p1[r]);
  float ps = 0;
#pragma unroll
  for (int r = 0; r < 16; ++r) ps += p0[r];
#pragma unroll
  for (int r = 0; r < 16; ++r) ps += p1[r];
  { auto rr = __builtin_amdgcn_permlane32_swap(__float_as_uint(ps), __float_as_uint(ps), false, false);
    ps = __uint_as_float(rr[0]) + __uint_as_float(rr[1]); }
  l_reg = l_reg * alpha + ps;
#define PK4(P, BASE, OUT) do { unsigned a0 = cvtpk(P[BASE + 0], P[BASE + 1]), a1 = cvtpk(P[BASE + 2], P[BASE + 3]);   \
    unsigned b0 = cvtpk(P[BASE + 4], P[BASE + 5]), b1 = cvtpk(P[BASE + 6], P[BASE + 7]);                              \
    auto r0 = __builtin_amdgcn_permlane32_swap(a0, b0, false, false); auto r1 = __builtin_amdgcn_permlane32_swap(a1, b1, false, false); \
    u32x4 w = {r0[0], r1[0], r0[1], r1[1]}; OUT = *reinterpret_cast<bf16x8*>(&w); } while (0)
  PK4(p0, 0, pa0); PK4(p0, 8, pa1); PK4(p1, 0, pa2); PK4(p1, 8, pa3);
#undef PK4
}
__device__ __forceinline__ void qkt(f32x16& p0, f32x16& p1, const char* Ks, const bf16x8* qr, int r32, int hi) {
  p0 = f32x16{}; p1 = f32x16{};
#pragma unroll
  for (int d0 = 0; d0 < 8; ++d0) { int cb = (d0 * 16 + hi * 8) * 2;
    bf16x8 b0 = *reinterpret_cast<const bf16x8*>(Ks + KSWZ(r32, cb));
    bf16x8 b1 = *reinterpret_cast<const bf16x8*>(Ks + KSWZ(32 + r32, cb));
    p0 = __builtin_amdgcn_mfma_f32_32x32x16_bf16(b0, qr[d0], p0, 0, 0, 0);
    p1 = __builtin_amdgcn_mfma_f32_32x32x16_bf16(b1, qr[d0], p1, 0, 0, 0); }
}
__device__ __forceinline__ int v_st(int k, int c) { const int kk = (k & ~0xC) | ((k & 4) << 1) | ((k & 8) >> 1); return ((kk >> 3) * 4 + (c >> 5)) * 512 + ((kk & 7) * 32 + (c & 31)) * 2; }
__device__ __forceinline__ int v_rd_base(int lane) { return ((lane & 3) << 3) | (((lane >> 2) & 3) << 6) | (((lane >> 4) & 1) << 5) | (((lane >> 5) & 1) << 8); }
constexpr int v_rd_off(int d0, int ks, int half) { return d0 * 512 + ks * 4096 + half * 2048; }
template <int OFF> __device__ __forceinline__ s16x4 tr_read(int vb) {
  s16x4 r; asm volatile("ds_read_b64_tr_b16 %0, %1 offset:%2" : "=&v"(r) : "v"(vb), "i"(OFF) : "memory"); return r;
}
template <int D0> __device__ __forceinline__ void pv_one(f32x16& od, int vb, bf16x8 pa0, bf16x8 pa1, bf16x8 pa2, bf16x8 pa3) {
  const s16x4 l0 = tr_read<v_rd_off(D0, 0, 0)>(vb), h0 = tr_read<v_rd_off(D0, 0, 1)>(vb), l1 = tr_read<v_rd_off(D0, 1, 0)>(vb), h1 = tr_read<v_rd_off(D0, 1, 1)>(vb);
  const s16x4 l2 = tr_read<v_rd_off(D0, 2, 0)>(vb), h2 = tr_read<v_rd_off(D0, 2, 1)>(vb), l3 = tr_read<v_rd_off(D0, 3, 0)>(vb), h3 = tr_read<v_rd_off(D0, 3, 1)>(vb);
  asm volatile("s_waitcnt lgkmcnt(0)" ::: "memory"); SBAR();
#define PK(L, H) (bf16x8){L[0], L[1], L[2], L[3], H[0], H[1], H[2], H[3]}
  od = __builtin_amdgcn_mfma_f32_32x32x16_bf16(pa0, PK(l0, h0), od, 0, 0, 0);
  od = __builtin_amdgcn_mfma_f32_32x32x16_bf16(pa1, PK(l1, h1), od, 0, 0, 0);
  od = __builtin_amdgcn_mfma_f32_32x32x16_bf16(pa2, PK(l2, h2), od, 0, 0, 0);
  od = __builtin_amdgcn_mfma_f32_32x32x16_bf16(pa3, PK(l3, h3), od, 0, 0, 0);
#undef PK
}
__device__ __forceinline__ void pv_d0(f32x16* o, int vb, bf16x8 pa0, bf16x8 pa1, bf16x8 pa2, bf16x8 pa3) {
  pv_one<0>(o[0], vb, pa0, pa1, pa2, pa3); pv_one<1>(o[1], vb, pa0, pa1, pa2, pa3); pv_one<2>(o[2], vb, pa0, pa1, pa2, pa3); pv_one<3>(o[3], vb, pa0, pa1, pa2, pa3);
}
#define PK4F(P, BASE, OUT) do { unsigned a0 = cvtpk(P[BASE + 0], P[BASE + 1]), a1 = cvtpk(P[BASE + 2], P[BASE + 3]);   \
    unsigned b0 = cvtpk(P[BASE + 4], P[BASE + 5]), b1 = cvtpk(P[BASE + 6], P[BASE + 7]);                              \
    auto r0 = __builtin_amdgcn_permlane32_swap(a0, b0, false, false); auto r1 = __builtin_amdgcn_permlane32_swap(a1, b1, false, false); \
    u32x4 w = {r0[0], r1[0], r0[1], r1[1]}; OUT = *reinterpret_cast<bf16x8*>(&w); } while (0)
__device__ __forceinline__ void qkt_fsm(f32x16& c0, f32x16& c1, const char* Ks, const bf16x8* qr, int r32, int hi,
                                        f32x16& p0, f32x16& p1, float& l_reg, bf16x8& pa0, bf16x8& pa1, bf16x8& pa2, bf16x8& pa3) {
  c0 = f32x16{}; c1 = f32x16{};
  bf16x8 kf0[3], kf1[3]; float ps = 0.f;
#define KLD(d) do { const int cb_ = ((d) * 16 + hi * 8) * 2; kf0[(d) % 3] = *reinterpret_cast<const bf16x8*>(Ks + KSWZ(r32, cb_)); kf1[(d) % 3] = *reinterpret_cast<const bf16x8*>(Ks + KSWZ(32 + r32, cb_)); } while (0)
#define KMM(d) do { c0 = __builtin_amdgcn_mfma_f32_32x32x16_bf16(kf0[(d) % 3], qr[d], c0, 0, 0, 0); c1 = __builtin_amdgcn_mfma_f32_32x32x16_bf16(kf1[(d) % 3], qr[d], c1, 0, 0, 0); } while (0)
#define EXP4(P, B) do { P[B] = __builtin_amdgcn_exp2f(P[B]); P[B + 1] = __builtin_amdgcn_exp2f(P[B + 1]); P[B + 2] = __builtin_amdgcn_exp2f(P[B + 2]); P[B + 3] = __builtin_amdgcn_exp2f(P[B + 3]); } while (0)
#define SUM8(P, B) do { ps += ((P[B] + P[B + 1]) + (P[B + 2] + P[B + 3])) + ((P[B + 4] + P[B + 5]) + (P[B + 6] + P[B + 7])); } while (0)
  KLD(0); KLD(1);
  KLD(2); KMM(0); EXP4(p1, 0);  SUM8(p0, 0); ATT0_INBAR;
  KLD(3); KMM(1); EXP4(p1, 4);  SUM8(p0, 8); ATT0_INBAR;
  KLD(4); KMM(2); EXP4(p1, 8);  PK4F(p0, 0, pa0); ATT0_INBAR;
  KLD(5); KMM(3); EXP4(p1, 12); PK4F(p0, 8, pa1); ATT0_INBAR;
  KLD(6); KMM(4); SUM8(p1, 0); ATT0_INBAR;
  KLD(7); KMM(5); SUM8(p1, 8); ATT0_INBAR;
  KMM(6); PK4F(p1, 0, pa2); ATT0_INBAR;
  KMM(7); PK4F(p1, 8, pa3);
  { auto rr = __builtin_amdgcn_permlane32_swap(__float_as_uint(ps), __float_as_uint(ps), false, false); ps = __uint_as_float(rr[0]) + __uint_as_float(rr[1]); }
  l_reg += ps;
#undef KLD
#undef KMM
#undef SUM8
}
template <int D0> __device__ __forceinline__ void pv_one_exp(f32x16& od, int vb, bf16x8 pa0, bf16x8 pa1, bf16x8 pa2, bf16x8 pa3, f32x16& pc0) {
  pv_one<D0>(od, vb, pa0, pa1, pa2, pa3); EXP4(pc0, 4 * D0);
}
__device__ __forceinline__ void pv_exp(f32x16* o, int vb, bf16x8 pa0, bf16x8 pa1, bf16x8 pa2, bf16x8 pa3, f32x16& pc0) {
  pv_one_exp<0>(o[0], vb, pa0, pa1, pa2, pa3, pc0); pv_one_exp<1>(o[1], vb, pa0, pa1, pa2, pa3, pc0); pv_one_exp<2>(o[2], vb, pa0, pa1, pa2, pa3, pc0); pv_one_exp<3>(o[3], vb, pa0, pa1, pa2, pa3, pc0);
}
#undef EXP4
#undef PK4F
__device__ __forceinline__ void nb_mask(f32x16& p0, f32x16& p1, int j, int lo, int qr_, int qc, int hi, const __attribute__((address_space(3))) float* rpbl) {
  if (j >= NB_WIN_TILES) return;
  const int kr = lo + j; int r0 = qr_ - 4; r0 = r0 < 0 ? 0 : (r0 > 248 ? 248 : r0);
  const float NEG = -INFINITY;
  if (kr < r0 || kr >= r0 + 8) {
#pragma unroll
    for (int x = 0; x < 16; ++x) { p0[x] = NEG; p1[x] = NEG; }
    return; }
  int c0 = qc - 8; c0 = c0 < 0 ? 0 : (c0 > 48 ? 48 : c0);
  const __attribute__((address_space(3))) float* row = rpbl + (kr - qr_ + 7) * 31 + 15 - qc;
#pragma unroll
  for (int x = 0; x < 16; ++x) {
    const int kc0 = crow(x, hi), kc1 = kc0 + 32;
    const bool v0 = (unsigned)(kc0 - c0) < 16u, v1 = (unsigned)(kc1 - c0) < 16u;
    const float b0 = row[v0 ? kc0 : qc], b1 = row[v1 ? kc1 : qc];
    p0[x] = v0 ? p0[x] + b0 : NEG; p1[x] = v1 ? p1[x] + b1 : NEG;
    if ((x & 3) == 3) SBAR(); }
}
struct NbArgs { int lo, qrow, qcol; const float* rpb_h;
                const float* gq; const float* rope; int q0; };

template <int MODE, int LDQ, int LDK, int LDO, int SDEPTH  >
__device__ __forceinline__ void attn_unit(const bf16* __restrict__ Qb, const bf16* __restrict__ Kh, const bf16* __restrict__ Vh, bf16* __restrict__ Ob, int kbase_, int NT_, char* lds, NbArgs nb, int wid_in  ) {
  const int kbase = (MODE == 0) ? 0 : kbase_, NT = (MODE == 0) ? ATT0_NT : NT_;
  int tid_ = threadIdx.x; (void)wid_in; asm volatile("" : "+v"(tid_));
  const int tid = tid_, wid = tid >> 6, lane = tid & 63, r32 = lane & 31, hi = lane >> 5;
  char* K_lds = lds; char* V_lds = lds + NRING * SHM_K;
  float* ws = (float*)(lds + WS_OFF) + wid * 64; float* li_l = ws; float* al_l = ws + 32;
  const __attribute__((address_space(3))) float* rpbl = (const __attribute__((address_space(3))) float*)(uintptr_t)((unsigned)(uintptr_t)lds + RPB_OFF);
  __syncthreads();
  if (MODE == 1) { for (int i = tid; i < 15 * 31; i += 512) ((float*)(lds + RPB_OFF))[i] = nb.rpb_h[i] * (1.f / SCALE); }
  float m_reg = -1e30f, l_reg = 0; f32x16 o[4] = {}; bf16x8 qr[8];
  const bf16* Qw = Qb + (long)(wid * QBLK + r32) * LDQ + hi * 8;
#pragma unroll
  for (int d0 = 0; d0 < 8; ++d0) qr[d0] = *reinterpret_cast<const bf16x8*>(Qw + d0 * 16);
  if (MODE == 0 && nb.gq != nullptr) {
    float qf[8][8]; float ss = 0.f;
#pragma unroll
    for (int d0 = 0; d0 < 8; ++d0) { const u32x4 w = *reinterpret_cast<const u32x4*>(&qr[d0]);
#pragma unroll
      for (int k = 0; k < 4; ++k) { const unsigned x = w[k]; qf[d0][2 * k] = __uint_as_float(x << 16); qf[d0][2 * k + 1] = __uint_as_float(x & 0xffff0000u); } }
#pragma unroll
    for (int d0 = 0; d0 < 8; ++d0)
#pragma unroll
      for (int j = 0; j < 8; ++j) ss += qf[d0][j] * qf[d0][j];
    { auto rr = __builtin_amdgcn_permlane32_swap(__float_as_uint(ss), __float_as_uint(ss), false, false); ss = __uint_as_float(rr[0]) + __uint_as_float(rr[1]); }
    const float rs = (1.f / sqrtf(ss * (1.f / 128.f) + 1e-6f)) * (SCALE * 1.4426950408889634f);
#pragma unroll
    for (int d0 = 0; d0 < 8; ++d0) { const float* gp = nb.gq + 16 * d0 + 8 * hi;
#pragma unroll
      for (int j = 0; j < 8; ++j) qf[d0][j] *= rs * gp[j]; SBAR(); }
    const int tok = nb.q0 + wid * QBLK + r32;
#pragma unroll
    for (int ax = 0; ax < 2; ++ax) { const int pos = ax ? (tok & 63) : (tok >> 6);
#pragma unroll
      for (int k = 0; k < 2; ++k) { const float* tb = nb.rope + (size_t)(pos * 32 + 16 * k + 8 * hi) * 2; const int da = 4 * ax + k, db = da + 2;
#pragma unroll
        for (int j = 0; j < 8; ++j) { const float c = tb[2 * j], s = tb[2 * j + 1], xa = qf[da][j], xb = qf[db][j];
          qf[da][j] = xa * c - xb * s; qf[db][j] = xb * c + xa * s; } SBAR(); } }
#pragma unroll
    for (int d0 = 0; d0 < 8; ++d0) { u32x4 w = {cvtpk(qf[d0][0], qf[d0][1]), cvtpk(qf[d0][2], qf[d0][3]), cvtpk(qf[d0][4], qf[d0][5]), cvtpk(qf[d0][6], qf[d0][7])}; qr[d0] = *reinterpret_cast<bf16x8*>(&w); }
  }
  const int vb0 = (int)(unsigned)(uintptr_t)V_lds + v_rd_base(lane);
#define KROW(t) (MODE != 1 ? kbase + (t) * KVBLK : ((t) < NB_WIN_TILES ? (nb.lo + (t)) * KVBLK : SEQ_LAT + ((t) - NB_WIN_TILES) * KVBLK))
#define RESC(a) do { if (__any((a) < 1.f)) { if (hi == 0) al_l[r32] = (a); asm volatile("s_waitcnt lgkmcnt(0)" ::: "memory"); \
    _Pragma("unroll") for (int d = 0; d < 4; ++d) _Pragma("unroll") for (int r = 0; r < 16; ++r) o[d][r] *= al_l[crow(r, hi)]; } } while (0)
#define NBM(P0, P1, t) do { if (MODE == 1) nb_mask(P0, P1, (t), nb.lo, nb.qrow, nb.qcol, hi, rpbl); } while (0)
#define VWAIT0() asm volatile("s_waitcnt vmcnt(0)" ::: "memory")
#define EXPA(P0) do { _Pragma("unroll") for (int r_ = 0; r_ < 16; ++r_) P0[r_] = __builtin_amdgcn_exp2f(P0[r_]); } while (0)
  typedef const __attribute__((address_space(1))) unsigned* gsrc_t; typedef __attribute__((address_space(3))) unsigned* ldst_t;
  const int wv_ = __builtin_amdgcn_readfirstlane(wid);
  unsigned koffA, koffB, voffA, voffB;
  { const int rowA = 8 * wv_ + (lane >> 4), rowB = rowA + 4, s_ = lane & 15;
    koffA = (unsigned)((rowA * LDK + ((s_ ^ (rowA & 7)) << 3)) * 2); koffB = (unsigned)((rowB * LDK + ((s_ ^ (rowB & 7)) << 3)) * 2);
    const int stA = 4 * wv_ + (lane >> 5), stB = stA + 2, kkA = (stA >> 2) * 8 + ((lane & 31) >> 2), kkB = (stB >> 2) * 8 + ((lane & 31) >> 2);
    const int kA = (kkA & ~0xC) | ((kkA & 4) << 1) | ((kkA & 8) >> 1), kB = (kkB & ~0xC) | ((kkB & 4) << 1) | ((kkB & 8) >> 1);
    voffA = (unsigned)((kA * LDK + (stA & 3) * 32 + (lane & 3) * 8) * 2); voffB = (unsigned)((kB * LDK + (stB & 3) * 32 + (lane & 3) * 8) * 2); }
  const unsigned kl_ = (unsigned)(uintptr_t)K_lds + (unsigned)wv_ * 2048u, vl_ = (unsigned)(uintptr_t)V_lds + (unsigned)wv_ * 2048u;
#define DMA_TILE(t, BO) do { const char* kt_ = (const char*)Kh + (size_t)KROW(t) * (size_t)(LDK * 2); const char* vt_ = (const char*)Vh + (size_t)KROW(t) * (size_t)(LDK * 2); \
    __builtin_amdgcn_global_load_lds((gsrc_t)(kt_ + koffA), (ldst_t)(uintptr_t)(kl_ + (unsigned)(BO)), 16, 0, 0); \
    __builtin_amdgcn_global_load_lds((gsrc_t)(kt_ + koffB), (ldst_t)(uintptr_t)(kl_ + (unsigned)(BO) + 1024u), 16, 0, 0); \
    __builtin_amdgcn_global_load_lds((gsrc_t)(vt_ + voffA), (ldst_t)(uintptr_t)(vl_ + (unsigned)(BO)), 16, 0, 0); \
    __builtin_amdgcn_global_load_lds((gsrc_t)(vt_ + voffB), (ldst_t)(uintptr_t)(vl_ + (unsigned)(BO) + 1024u), 16, 0, 0); } while (0)
  f32x16 pA0, pA1; float mnA, alA; bf16x8 pa0, pa1, pa2, pa3;
  if constexpr (MODE != 0) {
#define BAR_KEEP(ntl) do { if ((ntl) >= 2) asm volatile("s_waitcnt vmcnt(8) lgkmcnt(0)" ::: "memory"); else if ((ntl) == 1) asm volatile("s_waitcnt vmcnt(4) lgkmcnt(0)" ::: "memory"); \
    else asm volatile("s_waitcnt vmcnt(0) lgkmcnt(0)" ::: "memory"); __builtin_amdgcn_s_barrier(); asm volatile("" ::: "memory"); } while (0)
    DMA_TILE(0, 0); if (NT > 1) DMA_TILE(1, (int)SHM_K); if (NT > 2) DMA_TILE(2, 2 * (int)SHM_K);
    BAR_KEEP(NT > 2 ? 2 : (NT > 1 ? 1 : 0));
    for (int j = 0; j < NT; ++j) {
      const int b = (j & 3) * (int)SHM_K;
      if (j + 3 < NT) DMA_TILE(j + 3, ((j + 3) & 3) * (int)SHM_K);
      bool live = true;
      if (MODE == 1 && j < NB_WIN_TILES) { int r0_ = nb.qrow - 4; r0_ = r0_ < 0 ? 0 : (r0_ > 248 ? 248 : r0_); live = (nb.lo + j >= r0_) && (nb.lo + j < r0_ + 8); }
      if (live) {
      SBAR(); qkt(pA0, pA1, K_lds + b, qr, r32, hi); NBM(pA0, pA1, j);
      partialSM(pA0, pA1, m_reg, mnA, alA); RESC(alA);
      finishSM(pA0, pA1, alA, l_reg, pa0, pa1, pa2, pa3); SBAR();
      pv_d0(o, vb0 + b, pa0, pa1, pa2, pa3);
      }
      BAR_KEEP(j + 3 < NT ? 2 : (j + 2 < NT ? 1 : 0));
    }
#undef BAR_KEEP
  } else {
  f32x16 pB0, pB1;
#if ATT0_PRIO
  if (wv_ >= 4) __builtin_amdgcn_s_setprio(1);
#endif
#define BARK(more) do { if (more) asm volatile("s_waitcnt vmcnt(4) lgkmcnt(0)" ::: "memory"); else asm volatile("s_waitcnt vmcnt(0) lgkmcnt(0)" ::: "memory"); \
    __builtin_amdgcn_s_barrier(); asm volatile("" ::: "memory"); } while (0)
#define HSTEP(t, BC, BP, BN2, PC0, PC1, PP0, PP1) do { \
    const bool more_ = ((t) + 2 < NT); if (more_) DMA_TILE((t) + 2, BN2); \
    ATT0_LEADBAR; qkt_fsm(PC0, PC1, K_lds + (BC), qr, r32, hi, PP0, PP1, l_reg, pa0, pa1, pa2, pa3); ATT0_MIDBAR; \
    pv_exp(o, vb0 + (BP), pa0, pa1, pa2, pa3, PC0); \
    BARK(more_); } while (0)
  constexpr int B0 = 0, B1 = (int)SHM_K, B2 = 2 * (int)SHM_K, B3 = 3 * (int)SHM_K;
  static_assert((ATT0_NT - 4) % 4 == 0 && ATT0_NT >= 8, "MODE 0 tile count: two lead-in half-steps, then groups of four");
  DMA_TILE(0, B0); DMA_TILE(1, B1); BARK(true);
  DMA_TILE(2, B2);
  qkt(pA0, pA1, K_lds + B0, qr, r32, hi); EXPA(pA0);
  BARK(true);
  HSTEP(1, B1, B0, B3, pB0, pB1, pA0, pA1);
  HSTEP(2, B2, B1, B0, pA0, pA1, pB0, pB1);
  for (int j = 3; j + 3 < NT; j += 4) {
    HSTEP(j,     B3, B2, B1, pB0, pB1, pA0, pA1);
    HSTEP(j + 1, B0, B3, B2, pA0, pA1, pB0, pB1);
    HSTEP(j + 2, B1, B0, B3, pB0, pB1, pA0, pA1);
    HSTEP(j + 3, B2, B1, B0, pA0, pA1, pB0, pB1);
  }
  SBAR(); qkt(pB0, pB1, K_lds + B3, qr, r32, hi);
  finishSM(pA0, pA1, 1.f, l_reg, pa0, pa1, pa2, pa3); SBAR();
  pv_d0(o, vb0 + B2, pa0, pa1, pa2, pa3); EXPA(pB0);
  finishSM(pB0, pB1, 1.f, l_reg, pa0, pa1, pa2, pa3); SBAR();
  pv_d0(o, vb0 + B3, pa0, pa1, pa2, pa3);
#undef BARK
#if ATT0_PRIO
  __builtin_amdgcn_s_setprio(0);
#endif
  }
#undef DMA_TILE
#undef EXPA
#undef HSTEP
#undef VWAIT0
  if (hi == 0) li_l[r32] = l_reg; asm volatile("s_waitcnt lgkmcnt(0)" ::: "memory");
  float rli[16];
#pragma unroll
  for (int r = 0; r < 16; ++r) rli[r] = __builtin_amdgcn_rcpf(li_l[crow(r, hi)]);
  bf16* Ow = Ob + (long)(wid * QBLK) * LDO;
#pragma unroll
  for (int r = 0; r < 16; ++r) { const int orow = crow(r, hi);
#pragma unroll
    for (int d0 = 0; d0 < 4; d0 += 1) { const unsigned pk = cvtpk(o[d0][r] * rli[r], 0.f); Ow[(long)orow * LDO + d0 * 32 + r32] = (bf16)(pk & 0xffffu); } }
#undef KROW
#undef RESC
#undef NBM
}
#undef KSWZ
}
#define GAS __attribute__((address_space(1)))
#define LAS __attribute__((address_space(3)))
typedef unsigned short bf16;
typedef unsigned v4u __attribute__((ext_vector_type(4)));
typedef float f32x4 __attribute__((ext_vector_type(4)));
typedef short bf16x8 __attribute__((ext_vector_type(8)));
typedef GAS unsigned gu32;
typedef GAS unsigned long long gu64;
#define RLX_AGENT __ATOMIC_RELAXED, __HIP_MEMORY_SCOPE_AGENT
#define LDS_WAIT() asm volatile("s_waitcnt lgkmcnt(0)" ::: "memory")
#define VM_WAIT() asm volatile("s_waitcnt vmcnt(0)" ::: "memory")
__device__ __forceinline__ unsigned long long rt() { return __builtin_amdgcn_s_memrealtime(); }
__device__ __forceinline__ unsigned f2bf(float f) { unsigned u = __builtin_bit_cast(unsigned, f); return (u + 0x7fffu + ((u >> 16) & 1u)) >> 16; }
__device__ __forceinline__ unsigned pk2(float lo, float hi) { return f2bf(lo) | (f2bf(hi) << 16); }

#define XB_TMO      128
#define XB_XCNT(j)  (256  + 64 * (j))
#define XB_XSUB(j)  (1280 + 64 * (j))
#define XB_XGEN(j)  (2304 + 64 * (j))
#define XB_TOP      3328
#define XB_TOPGEN   3392
#define XCD_BAR_WORDS 3456
#define XB_SPIN_CAP (1u << 18)

__device__ __forceinline__ unsigned xb_ld(unsigned* p)              { return __hip_atomic_load(p, __ATOMIC_RELAXED, __HIP_MEMORY_SCOPE_AGENT); }
__device__ __forceinline__ unsigned xb_add(unsigned* p, unsigned v) { return __hip_atomic_fetch_add(p, v, __ATOMIC_RELAXED, __HIP_MEMORY_SCOPE_AGENT); }
__device__ __forceinline__ unsigned xb_xcc_id() { return (unsigned)__builtin_amdgcn_s_getreg((3 << 11) | 20) & 0xFu; }
#define XB_SPIN(cond, bar) do { unsigned _sp = 0; while (cond) { __builtin_amdgcn_s_sleep(1); \
    if ((++_sp & 255u) == 0u) { if (xb_ld(&(bar)[XB_TMO])) break; if (_sp > XB_SPIN_CAP) { atomicAdd(&(bar)[XB_TMO], 1u); break; } } } } while (0)

struct XcdBarrier {
    unsigned* bar; unsigned x;
    volatile LAS unsigned* st;
};

__device__ __forceinline__ XcdBarrier xcd_barrier_post(unsigned* bar, volatile LAS unsigned* st) {
    XcdBarrier b; b.bar = bar; b.x = xb_xcc_id(); b.st = st;
    if (threadIdx.x == 0) (void)xb_add(&bar[XB_XCNT(b.x)], 1u);
    return b;
}
__device__ __forceinline__ void xcd_barrier_complete(unsigned* bar, unsigned x, unsigned& nloc, unsigned& nx) {
    const unsigned G = gridDim.x * gridDim.y * gridDim.z;
    unsigned sum, cnt, mine, sp = 0u;
    for (;;) {
        sum = 0u; cnt = 0u; mine = 0u;
#pragma unroll
        for (unsigned j = 0; j < 16; ++j) { const unsigned c = xb_ld(&bar[XB_XCNT(j)]); sum += c; cnt += (c > 0u) ? 1u : 0u; mine = (j == x) ? c : mine; }
        if (sum == G) break;
        __builtin_amdgcn_s_sleep(1);
        if ((++sp & 255u) == 0u) { if (xb_ld(&bar[XB_TMO])) break; if (sp > XB_SPIN_CAP) { atomicAdd(&bar[XB_TMO], 1u); break; } }
    }
    nloc = mine > 0u ? mine : 1u; nx = cnt > 0u ? cnt : 1u;
}

__device__ __forceinline__ void xcd_barrier(const XcdBarrier& b) {
    asm volatile("s_waitcnt vmcnt(0)" ::: "memory");
    __syncthreads();
    if (threadIdx.x == 0) {
        unsigned* bar = b.bar;
        __builtin_amdgcn_s_waitcnt(0);
        unsigned nloc = b.st[0], nx = b.st[1];
        if (nloc == 0u) { xcd_barrier_complete(bar, b.x, nloc, nx); b.st[0] = nloc; b.st[1] = nx; }
        const unsigned old = xb_add(&bar[XB_XSUB(b.x)], 1u);
        const unsigned gen = old / nloc;
        if (old + 1u == (gen + 1u) * nloc) {
            __builtin_amdgcn_fence(__ATOMIC_RELEASE, "agent");
            asm volatile("s_waitcnt vmcnt(0)" ::: "memory");
            const unsigned og = xb_add(&bar[XB_TOP], 1u);
            const unsigned tg = og / nx;
            if (og + 1u == (tg + 1u) * nx) xb_add(&bar[XB_TOPGEN], 1u);
            else XB_SPIN(xb_ld(&bar[XB_TOPGEN]) == tg, bar);
            __builtin_amdgcn_fence(__ATOMIC_ACQUIRE, "agent");
            xb_add(&bar[XB_XGEN(b.x)], 1u);
            asm volatile("s_waitcnt vmcnt(0)" ::: "memory");
        } else {
            XB_SPIN(xb_ld(&bar[XB_XGEN(b.x)]) == gen, bar);
            __builtin_amdgcn_fence(__ATOMIC_ACQUIRE, "agent");
            asm volatile("s_waitcnt vmcnt(0)" ::: "memory");
        }
    }
    __syncthreads();
}

constexpr int NWAVES = 8;
constexpr int DM = 4096, SEQ = 16384, CTXL = 256, MTOT = SEQ + CTXL, DEPTH = 4, DFF = 6144, INC = 8192, RMOD = 256, NMOD = 9, MODW = NMOD * DM;
constexpr int CTX_PM = SEQ / 256;
constexpr float EPS = 1e-6f;
constexpr int C_QA = 0, C_KA = 2048, C_VA = 2560, C_QB = 3072, C_KB = 4096, C_VB = 5120, C_U = 6144, C_V = 7168;
constexpr int O_A = 0, O_B = 2048, O_C = 3072;
constexpr size_t MiB = 1u << 20;
constexpr size_t WS_CTL = 0, CTL_ZERO_BYTES = 1 * MiB;
constexpr size_t WS_MOD = 1 * MiB;
constexpr size_t WS_ROPE = 3 * MiB;
constexpr size_t WS_XR = 4 * MiB;
constexpr size_t WS_H = 264 * MiB;
constexpr size_t WS_ACT = 394 * MiB;
constexpr size_t WS_PROJ = 589 * MiB;
constexpr size_t WS_CAT = 849 * MiB;
#ifndef NSLAB_N
#define NSLAB_N 8
#endif
constexpr int NSLAB = NSLAB_N;
constexpr size_t WS_W1 = 1024 * MiB;
constexpr size_t WS_W2 = 1792 * MiB;
constexpr size_t WS_WMI = 2176 * MiB;
constexpr size_t WS_WMO = 2432 * MiB;
constexpr size_t WS_SLAB = 2560 * MiB;
constexpr size_t WS_DL = 2688 * MiB;
constexpr size_t WS_SLAB1 = 2944 * MiB;
constexpr size_t WS_SLAB2 = 2976 * MiB;
#ifndef NSL1_N
#define NSL1_N 4
#endif
#ifndef NSL2_N
#define NSL2_N 8
#endif
constexpr int NSL1 = NSL1_N, NSL2 = NSL2_N;
constexpr size_t WS_END = 3040 * MiB;
static_assert(WS_XR + (size_t)MTOT * DM * 4 <= WS_H && WS_H + (size_t)MTOT * DM * 2 <= WS_ACT && WS_ACT + (size_t)MTOT * DFF * 2 <= WS_PROJ && WS_PROJ + (size_t)MTOT * INC * 2 <= WS_CAT &&
              WS_CAT + (size_t)MTOT * DM * 2 <= WS_W1 && WS_W1 + 8ull * 2 * DFF * DM * 2 <= WS_W2 && WS_W2 + 8ull * DM * DFF * 2 <= WS_WMI && WS_WMI + 4ull * INC * DM * 2 <= WS_WMO &&
              WS_WMO + 4ull * DM * DM * 2 <= WS_SLAB && WS_SLAB + 2 * (size_t)NSLAB * 256 * DM * 4 <= WS_DL && WS_DL + 2 * (size_t)SEQ * DM * 2 <= WS_SLAB1 && WS_SLAB1 + (size_t)NSL1 * 256 * 2 * DFF * 2 <= WS_SLAB2 && WS_SLAB2 + (size_t)NSL2 * 256 * INC * 2 <= WS_END && WS_MOD + (size_t)DEPTH * 2 * MODW * 4 <= WS_ROPE && WS_ROPE + 256 * 32 * 2 * 4 <= WS_XR, "d_ws map");
constexpr int CW_BAR = 4096;
constexpr int CW_T = 16384;
constexpr int RING_OFF = 0, RING_BYTES = 131072;
constexpr int LDSCTL_OFF = RING_BYTES, MISC_OFF = LDSCTL_OFF + 320;
constexpr int LDS_BYTES = 147456;
static_assert(MISC_OFF + 128 <= LDS_BYTES, "LDS map");

__device__ const float INV_FREQ[32] = {
  1.000000000e+00f, 7.498942614e-01f, 5.623413324e-01f, 4.216965139e-01f, 3.162277639e-01f, 2.371373773e-01f, 1.778279394e-01f, 1.333521307e-01f,
  1.000000015e-01f, 7.498941571e-02f, 5.623413250e-02f, 4.216965288e-02f, 3.162277490e-02f, 2.371373773e-02f, 1.778279431e-02f, 1.333521493e-02f,
  9.999999776e-03f, 7.498941850e-03f, 5.623413250e-03f, 4.216964822e-03f, 3.162277630e-03f, 2.371373586e-03f, 1.778279431e-03f, 1.333521446e-03f,
  1.000000047e-03f, 7.498942432e-04f, 5.623413017e-04f, 4.216965172e-04f, 3.162277571e-04f, 2.371373703e-04f, 1.778279402e-04f, 1.333521504e-04f };

struct Frame {
    LAS unsigned char* lds;
    volatile LAS unsigned* MISC;
    gu32* ctl;
    int vcu, G, wid;
    float* out;
    unsigned char* ws;
};
enum { I_X = 0, I_C, I_CTX, I_CCTX, I_NORMG, I_WDOWN, I_WUP, I_MODB, I_FWIN, I_FWOUT, I_MWIN, I_MWOUT, I_QKG, I_RPB, I_SGUG, I_SGUW, I_SGUB, I_FING };

__device__ __forceinline__ const float* in_ptr(const Frame& F, int k) {
    unsigned a_ = (unsigned)LDSCTL_OFF + 8u * (unsigned)k; asm volatile("" : "+s"(a_));
    const volatile LAS unsigned* t = (const volatile LAS unsigned*)(uintptr_t)a_;
    const unsigned lo = __builtin_amdgcn_readfirstlane(t[0]), hi = __builtin_amdgcn_readfirstlane(t[1]);
    return (const float*)(const GAS float*)(((unsigned long long)hi << 32) | lo);
}
__device__ __forceinline__ unsigned char* wsl(const Frame& F) { GAS unsigned char* p = (GAS unsigned char*)F.ws; asm volatile("" : "+s"(p)); return (unsigned char*)p; }
#define P_MOD(F)  ((float*)(wsl(F) + WS_MOD))
#define P_ROPE(F) ((float*)(wsl(F) + WS_ROPE))
#define P_XR(F)   ((float*)(wsl(F) + WS_XR))
#define P_H(F)    ((bf16*)(wsl(F) + WS_H))
#define P_ACT(F)  ((bf16*)(wsl(F) + WS_ACT))
#define P_PROJ(F) ((bf16*)(wsl(F) + WS_PROJ))
#define P_CAT(F)  ((bf16*)(wsl(F) + WS_CAT))
#define P_SLAB(F) ((bf16*)(wsl(F) + WS_SLAB))
#define P_DL(F)   ((bf16*)(wsl(F) + WS_DL))
#define P_SLAB1(F) ((bf16*)(wsl(F) + WS_SLAB1))
#define P_SLAB2(F) ((bf16*)(wsl(F) + WS_SLAB2))
#define P_W1(F)   ((bf16*)(wsl(F) + WS_W1))
#define P_W2(F)   ((bf16*)(wsl(F) + WS_W2))
#define P_WMI(F)  ((bf16*)(wsl(F) + WS_WMI))
#define P_WMO(F)  ((bf16*)(wsl(F) + WS_WMO))
__device__ __forceinline__ int lane_id() { return (int)(threadIdx.x & 63); }
#define PH_IDS() int tid_ = threadIdx.x; asm volatile("" : "+v"(tid_)); const int tid = tid_, lane = tid & 63, wave = __builtin_amdgcn_readfirstlane(tid >> 6); (void)tid; (void)lane; (void)wave

__device__ __forceinline__ float wave_sum(float v) {
#pragma unroll
    for (int o = 1; o < 64; o <<= 1) v += __shfl_xor(v, o);
    return v;
}
__device__ __forceinline__ unsigned pkbf(float lo, float hi) { unsigned r; asm("v_cvt_pk_bf16_f32 %0, %1, %2" : "=v"(r) : "v"(lo), "v"(hi)); return r; }
__device__ __forceinline__ float bf_lo(unsigned w) { return __builtin_bit_cast(float, w << 16); }
__device__ __forceinline__ float bf_hi(unsigned w) { return __builtin_bit_cast(float, w & 0xffff0000u); }
__device__ __forceinline__ float gelu_tanh(float x) {
    const float z = 0.7978845608028654f * (x + 0.044715f * x * x * x);
    return x * __builtin_amdgcn_rcpf(1.f + __builtin_amdgcn_exp2f(z * -2.8853900817779268f));
}

#ifndef TR_NT
#define TR_NT 0
#endif
#if TR_NT
#define TR_LOAD(p) __builtin_nontemporal_load(p)
#define TR_STORE(v, p) __builtin_nontemporal_store(v, p)
#else
#ifndef TR_NT_LD
#define TR_NT_LD 0
#endif
#define TR_LOAD(p) (TR_NT_LD ? __builtin_nontemporal_load(p) : *(p))
#define TR_STORE(v, p) (*(p) = (v))
#endif
__device__ __forceinline__ void transpose_item(const float* W, int K, int N, bf16* WT, int k0, int n0, int drow0, LAS float* scr, int lane) {
    { float v[32];
      const float* wp = W + (size_t)(k0 + (lane >> 5)) * N + n0 + (lane & 31);
#pragma unroll
      for (int i = 0; i < 32; ++i) v[i] = TR_LOAD(wp + (size_t)(2 * i) * N);
#pragma unroll
      for (int i = 0; i < 32; ++i) scr[(2 * i + (lane >> 5)) * 33 + (lane & 31)] = v[i]; }
    LDS_WAIT(); asm volatile("" ::: "memory");
    const int c = lane & 7;
#pragma unroll
    for (int j = 0; j < 4; ++j) { const int n = (lane >> 3) + 8 * j; const LAS float* s = scr + (8 * c) * 33 + n;
        v4u o; o.x = pkbf(s[0 * 33], s[1 * 33]); o.y = pkbf(s[2 * 33], s[3 * 33]); o.z = pkbf(s[4 * 33], s[5 * 33]); o.w = pkbf(s[6 * 33], s[7 * 33]);
        TR_STORE(o, (GAS v4u*)(WT + (size_t)(drow0 + n) * K + k0 + 8 * c)); }
    LDS_WAIT(); asm volatile("" ::: "memory");
}

__device__ __forceinline__ void p0a(Frame& F, bool full) {
    PH_IDS();
    bf16* const W1 = P_W1(F); bf16* const W2 = P_W2(F); bf16* const WMI = P_WMI(F); bf16* const WMO = P_WMO(F); float* const ROPE = P_ROPE(F);
    LAS float* scr = (LAS float*)(F.lds + RING_OFF + wave * 16384);
    const int gw = F.vcu * NWAVES + wave, NGW = F.G * NWAVES;
    constexpr int I_W1 = (DM / 64) * (2 * DFF / 32), I_W2 = (DFF / 64) * (DM / 32), I_MI = (DM / 64) * (INC / 32), I_MO = (DM / 64) * (DM / 32);
    constexpr int N_W1 = 8 * I_W1, N_W2 = 8 * I_W2, N_MI = 4 * I_MI, N_MO = 4 * I_MO, NITEMS = N_W1 + N_W2 + N_MI + N_MO;
    for (int it = gw; it < NITEMS; it += NGW) {
        int r = it;
        if (r < N_W1) { const int mat = r / I_W1; r -= mat * I_W1; const int nblk = 2 * DFF / 32, kb = r / nblk, nb = r % nblk, n0 = 32 * nb;
            const int drow0 = n0 < DFF ? ((n0 >> 7) * 256 + (n0 & 127)) : (((n0 - DFF) >> 7) * 256 + 128 + ((n0 - DFF) & 127));
            transpose_item(in_ptr(F, I_FWIN) + (size_t)mat * DM * 2 * DFF, DM, 2 * DFF, W1 + (size_t)mat * 2 * DFF * DM, 64 * kb, n0, drow0, scr, lane); continue; }
        r -= N_W1;
        if (r < N_W2) { const int mat = r / I_W2; r -= mat * I_W2; const int nblk = DM / 32, kb = r / nblk, nb = r % nblk;
            transpose_item(in_ptr(F, I_FWOUT) + (size_t)mat * DFF * DM, DFF, DM, W2 + (size_t)mat * DM * DFF, 64 * kb, 32 * nb, 32 * nb, scr, lane); continue; }
        r -= N_W2;
        if (r < N_MI) { const int mat = r / I_MI; r -= mat * I_MI; const int nblk = INC / 32, kb = r / nblk, nb = r % nblk;
            transpose_item(in_ptr(F, I_MWIN) + (size_t)mat * DM * INC, DM, INC, WMI + (size_t)mat * INC * DM, 64 * kb, 32 * nb, 32 * nb, scr, lane); continue; }
        r -= N_MI;
        { const int mat = r / I_MO; r -= mat * I_MO; const int nblk = DM / 32, kb = r / nblk, nb = r % nblk;
            transpose_item(in_ptr(F, I_MWOUT) + (size_t)mat * DM * DM, DM, DM, WMO + (size_t)mat * DM * DM, 64 * kb, 32 * nb, 32 * nb, scr, lane); }
    }
    if (!full) return;
    { const int gid = F.vcu * (NWAVES * 64) + tid;
      if (gid < 256 * 32) { const int pos = gid >> 5, i = gid & 31; const float angf = (float)pos * INV_FREQ[i]; const double a = (double)angf;
        const double nq = __builtin_rint(a * 0.63661977236758134308); const double rr = (a - nq * 1.5707963267948966192) - nq * 6.123233995736766e-17; const double r2 = rr * rr;
        const double sn = rr * (1.0 + r2 * (-1.0 / 6 + r2 * (1.0 / 120 + r2 * (-1.0 / 5040 + r2 * (1.0 / 362880 + r2 * (-1.0 / 39916800 + r2 * (1.0 / 6227020800.0)))))));
        const double cs = 1.0 + r2 * (-0.5 + r2 * (1.0 / 24 + r2 * (-1.0 / 720 + r2 * (1.0 / 40320 + r2 * (-1.0 / 3628800 + r2 * (1.0 / 479001600.0 + r2 * (-1.0 / 87178291200.0)))))));
        const int q = ((int)nq) & 3; const double c_ = (q == 0) ? cs : (q == 1) ? -sn : (q == 2) ? -cs : sn; const double s_ = (q == 0) ? sn : (q == 1) ? cs : (q == 2) ? -sn : -cs;
        ROPE[2 * gid] = (float)c_; ROPE[2 * gid + 1] = (float)s_; } }
    __syncthreads();
    for (int item = F.vcu; item < 256; item += F.G) {
        const int l = item >> 6, ch = item & 63; const float* Wd = in_ptr(F, I_WDOWN) + (size_t)l * DM * RMOD;
        f32x4 a0 = {0.f, 0.f, 0.f, 0.f}, a1 = a0;
#pragma unroll
        for (int i = 0; i < 8; ++i) { const int d = ch * 64 + wave * 8 + i; const float cv = in_ptr(F, I_C)[d], cc = in_ptr(F, I_CCTX)[d];
            const float s0 = cv / (1.f + __expf(-cv)), s1 = cc / (1.f + __expf(-cc)); const f32x4 w = *(const GAS f32x4*)(Wd + (size_t)d * RMOD + 4 * lane);
            a0 += w * s0; a1 += w * s1; }
        LAS float* red = (LAS float*)(F.lds + RING_OFF) + wave * 512;
        *(LAS f32x4*)(red + 4 * lane) = a0; *(LAS f32x4*)(red + 256 + 4 * lane) = a1;
        __syncthreads();
        { const LAS float* rb = (const LAS float*)(F.lds + RING_OFF) + tid; float s = 0.f;
#pragma unroll
          for (int w = 0; w < 8; ++w) s += rb[w * 512];
          atomicAdd((float*)(F.ctl + CW_T) + l * 512 + tid, s); }
        __syncthreads();
    }
}
__device__ __forceinline__ void p0b(Frame& F) {
    PH_IDS();
    float* const MOD = P_MOD(F);
    LAS float* tl = (LAS float*)(F.lds + RING_OFF); LAS f32x4* part = (LAS f32x4*)(F.lds + RING_OFF + 4096);
    for (int item = F.vcu; item < DEPTH * 36; item += F.G) {
        const int l = item / 36, jb = item % 36;
        tl[tid] = ((const GAS float*)(F.ctl + CW_T))[l * 512 + tid];
        __syncthreads();
        const int jl = tid & 255, rh = tid >> 8, j = (jb * 256 + jl) * 4;
        const float* Wu = in_ptr(F, I_WUP) + (size_t)l * RMOD * MODW + j;
        f32x4 a0 = {0.f, 0.f, 0.f, 0.f}, a1 = a0;
#pragma unroll 8
        for (int r = rh * 128; r < rh * 128 + 128; ++r) { const f32x4 w = *(const GAS f32x4*)(Wu + (size_t)r * MODW); a0 += w * tl[r]; a1 += w * tl[256 + r]; }
        if (rh == 1) { part[jl * 2] = a0; part[jl * 2 + 1] = a1; }
        __syncthreads();
        if (rh == 0) { const f32x4 b = *(const GAS f32x4*)(in_ptr(F, I_MODB) + (size_t)l * MODW + j); a0 += part[jl * 2] + b; a1 += part[jl * 2 + 1] + b;
            *(GAS f32x4*)(MOD + (size_t)(l * 2 + 0) * MODW + j) = a0; *(GAS f32x4*)(MOD + (size_t)(l * 2 + 1) * MODW + j) = a1; }
        __syncthreads();
    }
}
template <bool FINAL>
__device__ __forceinline__ void norm_phase(Frame& F, const float* g, const float* modl, const float* modc, int i_shift, int i_scale, bf16* H, float* out, int mrows, const float* xlat  , const float* xctx  , int nslab, int npend  , bool wb  , bool down  ) {
    PH_IDS();
    float* const XR = P_XR(F); const bf16* const SLAB = P_SLAB(F); const bf16* const DL = P_DL(F);
    LAS float* gs = (LAS float*)(F.lds + RING_OFF); LAS float* sh = gs + DM;
    { float ga[DM / (NWAVES * 64)], sa[DM / (NWAVES * 64)], ha[DM / (NWAVES * 64)];
#pragma unroll
      for (int i = 0; i < DM / (NWAVES * 64); ++i) { const int j = tid + i * NWAVES * 64; ga[i] = ((const GAS float*)g)[j];
          if (!FINAL) { sa[i] = ((const GAS float*)modl)[i_scale * DM + j]; ha[i] = ((const GAS float*)modl)[i_shift * DM + j]; } else { sa[i] = 0.f; ha[i] = 0.f; } }
#pragma unroll
      for (int i = 0; i < DM / (NWAVES * 64); ++i) { const int j = tid + i * NWAVES * 64; gs[j] = ga[i] * (1.f + sa[i]); if (!FINAL) sh[j] = ha[i]; } }
    __syncthreads();
    const bool heavy = !FINAL && (mrows > SEQ) && (nslab > 0);
    const int mstep = F.G * NWAVES, mend = mrows;
    int mstat = F.vcu * NWAVES + wave, mc = SEQ + F.vcu;
    LAS unsigned* const rowcnt = (LAS unsigned*)(F.lds + RING_OFF + 32768);
    if (heavy) { if (tid == 0) *rowcnt = 0u; __syncthreads(); }
    for (;;) {
        int m;
#ifndef NORM_DOWN
#define NORM_DOWN 1
#endif
        if (!heavy) { m = mstat; mstat += mstep; if (m >= mend) break;
                      if (NORM_DOWN && down && m < SEQ) { const int w0 = F.vcu * NWAVES + wave, cntw = (SEQ - w0 + mstep - 1) / mstep, k_ = (m - w0) / mstep; m = w0 + (cntw - 1 - k_) * mstep; } }
        else if (wave == 7 && mc < MTOT) { m = mc; mc += F.G; }
        else { unsigned i_ = 0u; if (lane == 0) i_ = __hip_atomic_fetch_add(rowcnt, 1u, __ATOMIC_RELAXED, __HIP_MEMORY_SCOPE_WORKGROUP);
               const int ii_ = (int)__builtin_amdgcn_readfirstlane(i_), cnt_ = (SEQ - F.vcu + F.G - 1) / F.G; if (ii_ >= cnt_) break;
               m = F.vcu + ((NORM_DOWN && down) ? cnt_ - 1 - ii_ : ii_) * F.G; }
        asm volatile("" ::: "memory");
        GAS f32x4* xr = (GAS f32x4*)(XR + (size_t)m * DM) + lane;
        const GAS f32x4* xin = (const GAS f32x4*)(m < SEQ ? xlat + (size_t)m * DM : xctx + (size_t)(m - SEQ) * DM) + lane;
        f32x4 v[16]; float ss = 0.f;
#pragma unroll
#ifndef H_NT
#define H_NT 0
#endif
#ifndef DL_NT
#define DL_NT 1
#endif
#ifndef NORM_NT_ST
#define NORM_NT_ST 1
#endif
#ifndef NORM_NT
#define NORM_NT 1
#endif
        for (int j = 0; j < 16; ++j) v[j] = NORM_NT ? __builtin_nontemporal_load(&xin[64 * j]) : xin[64 * j];
#ifndef NO_DADD
        if (npend > 0 && m < SEQ) {
            const GAS unsigned long long* dp0 = (const GAS unsigned long long*)(DL + (size_t)m * DM) + lane;
            const GAS unsigned long long* dp1 = (const GAS unsigned long long*)(DL + (size_t)SEQ * DM + (size_t)m * DM) + lane;
            unsigned long long d0[16], d1[16];
#pragma unroll
            for (int j = 0; j < 16; ++j) d0[j] = DL_NT ? __builtin_nontemporal_load(&dp0[64 * j]) : dp0[64 * j];
            if (npend > 1) {
#pragma unroll
                for (int j = 0; j < 16; ++j) d1[j] = DL_NT ? __builtin_nontemporal_load(&dp1[64 * j]) : dp1[64 * j];
            } else {
#pragma unroll
                for (int j = 0; j < 16; ++j) d1[j] = 0ull;
            }
#pragma unroll
            for (int j = 0; j < 16; ++j) { const unsigned lo = (unsigned)d0[j], hi_ = (unsigned)(d0[j] >> 32), lo1 = (unsigned)d1[j], hi1 = (unsigned)(d1[j] >> 32);
                v[j].x += bf_lo(lo) + bf_lo(lo1); v[j].y += bf_hi(lo) + bf_hi(lo1); v[j].z += bf_lo(hi_) + bf_lo(hi1); v[j].w += bf_hi(hi_) + bf_hi(hi1); }
            if (!FINAL && wb) {
#pragma unroll
                for (int j = 0; j < 16; ++j) { if (NORM_NT_ST) __builtin_nontemporal_store(v[j], &xr[64 * j]); else xr[64 * j] = v[j]; } }
        }
#endif
        if (!FINAL && m >= SEQ && nslab > 0) {
            for (int s_ = 0; s_ < nslab; ++s_) { const GAS unsigned long long* sp = (const GAS unsigned long long*)(SLAB + ((size_t)s_ * 256 + (m - SEQ)) * DM) + lane;
#pragma unroll
                for (int j = 0; j < 16; ++j) { const unsigned long long d = __builtin_nontemporal_load(&sp[64 * j]); const unsigned lo = (unsigned)d, hi_ = (unsigned)(d >> 32);
                    v[j].x += bf_lo(lo); v[j].y += bf_hi(lo); v[j].z += bf_lo(hi_); v[j].w += bf_hi(hi_); } }
#pragma unroll
            for (int j = 0; j < 16; ++j) xr[64 * j] = v[j];
        }
#pragma unroll
        for (int j = 0; j < 16; ++j) ss += (v[j].x * v[j].x + v[j].y * v[j].y) + (v[j].z * v[j].z + v[j].w * v[j].w);
        const float rstd = 1.f / sqrtf(wave_sum(ss) * (1.f / DM) + EPS);
        if (FINAL) { GAS f32x4* o = (GAS f32x4*)(out + (size_t)m * DM) + lane;
#pragma unroll
            for (int j = 0; j < 16; ++j) o[64 * j] = v[j] * rstd * *(const LAS f32x4*)(gs + 256 * j + 4 * lane);
        } else {
            GAS unsigned long long* o8 = (GAS unsigned long long*)(H + (size_t)m * DM) + lane;
            if (m < SEQ) {
#pragma unroll
                for (int j = 0; j < 16; ++j) { const f32x4 y = v[j] * rstd * *(const LAS f32x4*)(gs + 256 * j + 4 * lane) + *(const LAS f32x4*)(sh + 256 * j + 4 * lane);
                    const unsigned long long pk_ = (unsigned long long)pkbf(y.x, y.y) | ((unsigned long long)pkbf(y.z, y.w) << 32); if (H_NT) __builtin_nontemporal_store(pk_, &o8[64 * j]); else o8[64 * j] = pk_; }
            } else {
                int lc_ = lane; asm volatile("" : "+v"(lc_));
#pragma unroll
                for (int j = 0; j < 16; ++j) { const int c = 256 * j + 4 * lc_; const f32x4 gg = *(const GAS f32x4*)(g + c) * (*(const GAS f32x4*)(modc + i_scale * DM + c) + 1.f);
                    const f32x4 y = v[j] * rstd * gg + *(const GAS f32x4*)(modc + i_shift * DM + c);
                    o8[64 * j] = (unsigned long long)pkbf(y.x, y.y) | ((unsigned long long)pkbf(y.z, y.w) << 32);
                    if ((j & 3) == 3) asm volatile("" ::: "memory"); }
            }
        }
    }
}
__device__ __forceinline__ void ctx_fix_ffn(Frame& F) {
    PH_IDS();
    const bf16* const SL = P_SLAB1(F); bf16* const ACT = P_ACT(F);
    for (int r = F.vcu; r < CTXL; r += F.G)
        for (int c = tid; c < DFF / 8; c += NWAVES * 64) { const int j0 = 8 * c, ca = ((j0 >> 7) << 8) + (j0 & 127);
            float a[8] = {0.f, 0.f, 0.f, 0.f, 0.f, 0.f, 0.f, 0.f}, b[8] = {0.f, 0.f, 0.f, 0.f, 0.f, 0.f, 0.f, 0.f};
#pragma unroll
            for (int s_ = 0; s_ < NSL1; ++s_) { const bf16* p = SL + ((size_t)s_ * 256 + r) * (2 * DFF) + ca; const v4u wa = __builtin_nontemporal_load((const GAS v4u*)p), wb = __builtin_nontemporal_load((const GAS v4u*)(p + 128));
                a[0] += bf_lo(wa.x); a[1] += bf_hi(wa.x); a[2] += bf_lo(wa.y); a[3] += bf_hi(wa.y); a[4] += bf_lo(wa.z); a[5] += bf_hi(wa.z); a[6] += bf_lo(wa.w); a[7] += bf_hi(wa.w);
                b[0] += bf_lo(wb.x); b[1] += bf_hi(wb.x); b[2] += bf_lo(wb.y); b[3] += bf_hi(wb.y); b[4] += bf_lo(wb.z); b[5] += bf_hi(wb.z); b[6] += bf_lo(wb.w); b[7] += bf_hi(wb.w); }
            float o[8];
#pragma unroll
            for (int e = 0; e < 8; ++e) o[e] = (a[e] * __builtin_amdgcn_rcpf(1.f + __builtin_amdgcn_exp2f(a[e] * -1.4426950408889634f))) * b[e];
            v4u w; w.x = pkbf(o[0], o[1]); w.y = pkbf(o[2], o[3]); w.z = pkbf(o[4], o[5]); w.w = pkbf(o[6], o[7]);
            *(GAS v4u*)(ACT + (size_t)(SEQ + r) * DFF + j0) = w; }
}
__device__ __forceinline__ void ctx_fix_proj(Frame& F) {
    PH_IDS();
    const bf16* const SL = P_SLAB2(F); bf16* const PROJ = P_PROJ(F);
    for (int r = F.vcu; r < CTXL; r += F.G)
        for (int c = tid; c < INC / 8; c += NWAVES * 64) { const int j0 = 8 * c;
            float a[8] = {0.f, 0.f, 0.f, 0.f, 0.f, 0.f, 0.f, 0.f};
#pragma unroll
            for (int s_ = 0; s_ < NSL2; ++s_) { const v4u wa = __builtin_nontemporal_load((const GAS v4u*)(SL + ((size_t)s_ * 256 + r) * INC + j0));
                a[0] += bf_lo(wa.x); a[1] += bf_hi(wa.x); a[2] += bf_lo(wa.y); a[3] += bf_hi(wa.y); a[4] += bf_lo(wa.z); a[5] += bf_hi(wa.z); a[6] += bf_lo(wa.w); a[7] += bf_hi(wa.w); }
            v4u w; w.x = pkbf(a[0], a[1]); w.y = pkbf(a[2], a[3]); w.z = pkbf(a[4], a[5]); w.w = pkbf(a[6], a[7]);
            *(GAS v4u*)(PROJ + (size_t)(SEQ + r) * INC + j0) = w; }
}
__device__ __forceinline__ void qknorm_rows(Frame& F, const float* qkg  , bool skip_lat_q  ) {
    PH_IDS();
    bf16* const PROJ = P_PROJ(F); const float* const ROPE = P_ROPE(F);
    const int gw = F.vcu * NWAVES + wave, NGW = F.G * NWAVES, hq = lane >> 4, q = lane & 15;
    for (int m = gw + ((MTOT - 1 - gw) / NGW) * NGW; m >= 0; m -= NGW) {
        bf16* prow = PROJ + (size_t)m * INC;
        const int pos = (q < 8) ? (m >> 6) : (m & 63);
        f32x4 cs[4];
        if (m < SEQ) { const GAS f32x4* tb = (const GAS f32x4*)(ROPE + (size_t)(pos * 32 + (q & 3) * 8) * 2);
#pragma unroll
            for (int e = 0; e < 4; ++e) cs[e] = tb[e]; }
        v4u raws[5];
        const int st0 = (skip_lat_q && m < SEQ) ? 4 : 0;
#pragma unroll
        for (int st = 0; st < 5; ++st) if (st >= st0) raws[st] = *(const GAS v4u*)(prow + (st * 4 + hq) * 128 + 8 * q);
#pragma unroll
        for (int st = 0; st < 5; ++st) { if (st < st0) continue;
            const int hh = st * 4 + hq; GAS v4u* p = (GAS v4u*)(prow + hh * 128 + 8 * q); const v4u raw = raws[st];
            float v[8] = {bf_lo(raw.x), bf_hi(raw.x), bf_lo(raw.y), bf_hi(raw.y), bf_lo(raw.z), bf_hi(raw.z), bf_lo(raw.w), bf_hi(raw.w)};
            float ss = 0.f;
#pragma unroll
            for (int e = 0; e < 8; ++e) ss += v[e] * v[e];
            ss += __shfl_xor(ss, 1); ss += __shfl_xor(ss, 2); ss += __shfl_xor(ss, 4); ss += __shfl_xor(ss, 8);
            const float rstd = 1.f / sqrtf(ss * (1.f / 128.f) + EPS);
            const float* gp = qkg + (st == 4 ? 128 : 0) + 8 * q; const f32x4 g0 = *(const f32x4*)gp, g1 = *(const f32x4*)(gp + 4);
            const float gg[8] = {g0.x, g0.y, g0.z, g0.w, g1.x, g1.y, g1.z, g1.w};
#pragma unroll
            for (int e = 0; e < 8; ++e) v[e] = v[e] * rstd * gg[e];
            if (m < SEQ) {
#pragma unroll
                for (int e = 0; e < 8; ++e) { const float yp = __shfl_xor(v[e], 4); const float c = (e & 1) ? cs[e >> 1].z : cs[e >> 1].x, s = (e & 1) ? cs[e >> 1].w : cs[e >> 1].y;
                    v[e] = (q & 4) ? (v[e] * c + yp * s) : (v[e] * c - yp * s); } }
            v4u o; o.x = pkbf(v[0], v[1]); o.y = pkbf(v[2], v[3]); o.z = pkbf(v[4], v[5]); o.w = pkbf(v[6], v[7]); *p = o;
        }
    }
}
__device__ __forceinline__ bool attn_noshift_ok(const float* qkg) {
    const int lane = lane_id();
    float gq = fmaxf(fabsf(qkg[lane]), fabsf(qkg[64 + lane])), gk = fmaxf(fabsf(qkg[128 + lane]), fabsf(qkg[192 + lane]));
#pragma unroll
    for (int o = 1; o < 64; o <<= 1) { gq = fmaxf(gq, __shfl_xor(gq, o)); gk = fmaxf(gk, __shfl_xor(gk, o)); }
    const float M = 11.313708499f * gq * gk;
#ifdef FORCE_ONLINE_MAX
    return false;
#endif
    return __builtin_amdgcn_readfirstlane((M <= 38.f) ? 1 : 0) != 0;
}
constexpr int SV_PITCH = 132;
constexpr int VNT_PITCH = 136;
__device__ __forceinline__ void sgu_unit(Frame& F, int n, int g, const float* gv  , const float* Wsl  , const float* bsl  ) {
    LAS bf16* VNT = (LAS bf16*)(F.lds + RING_OFF);
    PH_IDS();
    const bf16* const PROJ = P_PROJ(F); bf16* const CAT = P_CAT(F);
    const size_t row0 = (size_t)n * 128;
    __syncthreads();
#pragma unroll
    for (int i = 0; i < 4; ++i) { const int pid = tid + 512 * i, q = pid >> 4, c0 = (pid & 15) * 8;
        const v4u raw = __builtin_nontemporal_load((const GAS v4u*)(PROJ + (row0 + q) * INC + C_V + g * 128 + c0));
        float v[8] = {bf_lo(raw.x), bf_hi(raw.x), bf_lo(raw.y), bf_hi(raw.y), bf_lo(raw.z), bf_hi(raw.z), bf_lo(raw.w), bf_hi(raw.w)};
        float ss = 0.f;
#pragma unroll
        for (int e = 0; e < 8; ++e) { v[e] = gelu_tanh(v[e]); ss += v[e] * v[e]; }
        ss += __shfl_xor(ss, 1); ss += __shfl_xor(ss, 2); ss += __shfl_xor(ss, 4); ss += __shfl_xor(ss, 8);
        const float rstd = 1.f / sqrtf(ss * (1.f / 128.f) + EPS);
        const float* gp = gv + g * 128 + c0; const f32x4 g0 = *(const f32x4*)gp, g1 = *(const f32x4*)(gp + 4);
        const float gg[8] = {g0.x, g0.y, g0.z, g0.w, g1.x, g1.y, g1.z, g1.w};
#pragma unroll
        for (int e = 0; e < 8; ++e) { const unsigned pk = pkbf(v[e] * rstd * gg[e], 0.f); VNT[(c0 + e) * VNT_PITCH + q] = (bf16)(pk & 0xffffu); } }
    __syncthreads();
    const int pb = wave & 3, ch = wave >> 2, r32 = lane & 31, hi = lane >> 5;
    att::f32x16 acc0 = {}, acc1 = {};
    const float* wrow = Wsl + ((size_t)g * 128 + pb * 32 + r32) * 128 + 8 * hi;
#pragma unroll
    for (int ks = 0; ks < 8; ++ks) {
        const f32x4 w0 = *(const f32x4*)(wrow + 16 * ks), w1 = *(const f32x4*)(wrow + 16 * ks + 4);
        v4u aw; aw.x = pkbf(w0.x, w0.y); aw.y = pkbf(w0.z, w0.w); aw.z = pkbf(w1.x, w1.y); aw.w = pkbf(w1.z, w1.w);
        const bf16x8 af = __builtin_bit_cast(bf16x8, aw);
        const bf16x8 b0 = *(const LAS bf16x8*)(VNT + (64 * ch + r32) * VNT_PITCH + 16 * ks + 8 * hi);
        const bf16x8 b1 = *(const LAS bf16x8*)(VNT + (64 * ch + 32 + r32) * VNT_PITCH + 16 * ks + 8 * hi);
        acc0 = __builtin_amdgcn_mfma_f32_32x32x16_bf16(af, b0, acc0, 0, 0, 0);
        acc1 = __builtin_amdgcn_mfma_f32_32x32x16_bf16(af, b1, acc1, 0, 0, 0); }
    LAS float* SVL = (LAS float*)(F.lds + RING_OFF + 40960);
#pragma unroll
    for (int r = 0; r < 16; ++r) { const int p = pb * 32 + att::crow(r, hi); const float bs = bsl[g * 128 + p];
        SVL[p * SV_PITCH + 64 * ch + r32] = acc0[r] + bs; SVL[p * SV_PITCH + 64 * ch + 32 + r32] = acc1[r] + bs; }
    __syncthreads();
#pragma unroll
    for (int i = 0; i < 4; ++i) { const int cid = tid + 512 * i, p = cid >> 4, c0 = (cid & 15) * 8;
        const v4u raw = __builtin_nontemporal_load((const GAS v4u*)(PROJ + (row0 + p) * INC + C_U + g * 128 + c0));
        const f32x4 s0 = *(const LAS f32x4*)(SVL + p * SV_PITCH + c0), s1 = *(const LAS f32x4*)(SVL + p * SV_PITCH + c0 + 4);
        v4u o; o.x = pkbf(gelu_tanh(bf_lo(raw.x)) * s0.x, gelu_tanh(bf_hi(raw.x)) * s0.y); o.y = pkbf(gelu_tanh(bf_lo(raw.y)) * s0.z, gelu_tanh(bf_hi(raw.y)) * s0.w);
        o.z = pkbf(gelu_tanh(bf_lo(raw.z)) * s1.x, gelu_tanh(bf_hi(raw.z)) * s1.y); o.w = pkbf(gelu_tanh(bf_lo(raw.w)) * s1.z, gelu_tanh(bf_hi(raw.w)) * s1.w);
        *(GAS v4u*)(CAT + (row0 + p) * DM + O_C + g * 128 + c0) = o; }
}

#ifndef ATT1_SDEPTH
#define ATT1_SDEPTH 1
#endif
#ifndef ATT0_SDEPTH
#define ATT0_SDEPTH 1
#endif
#ifndef G1_ALIGN
#define G1_ALIGN true
#endif
#ifndef MINI_FIRST
#define MINI_FIRST 0
#endif
#ifndef RESID_ALIGN
#define RESID_ALIGN true
#endif
#ifndef INPROJ_COLMAJOR
#define INPROJ_COLMAJOR 0
#endif
#ifndef GEMM_REV
#define GEMM_REV 0
#endif
#ifndef PROBE_DBL
#define PROBE_DBL 0
#endif
#define REPS(k) ((PROBE_DBL == (k)) ? 2 : 1)
struct Args { const float* in[18]; float* out; unsigned char* ws; };
__global__ void __launch_bounds__(NWAVES * 64, 2) dit_fwd(Args args) {
    extern __shared__ __attribute__((aligned(16))) unsigned char lds[];
    Frame F;
    F.lds = (LAS unsigned char*)lds;
    F.MISC = (volatile LAS unsigned*)(F.lds + MISC_OFF);
    F.wid = __builtin_amdgcn_readfirstlane((int)(threadIdx.x >> 6));
    F.G = gridDim.x; { const int bx = blockIdx.x; F.vcu = (F.G % 8 == 0) ? (bx % 8) * (F.G / 8) + bx / 8 : bx; }
    unsigned char* ws = args.ws;
    F.ctl = (gu32*)(ws + WS_CTL);
    F.out = args.out;
    F.ws = ws;
    for (int u = threadIdx.x; u < (LDS_BYTES - LDSCTL_OFF) / 4; u += NWAVES * 64) ((LAS unsigned*)(F.lds + LDSCTL_OFF))[u] = 0u;
    __syncthreads();
    if (threadIdx.x < 18) { const unsigned long long p = (unsigned long long)(uintptr_t)args.in[threadIdx.x]; ((LAS unsigned*)(F.lds + LDSCTL_OFF))[2 * threadIdx.x] = (unsigned)p; ((LAS unsigned*)(F.lds + LDSCTL_OFF))[2 * threadIdx.x + 1] = (unsigned)(p >> 32); }
    __syncthreads();
    XcdBarrier bar = xcd_barrier_post((unsigned*)(F.ctl + CW_BAR), F.MISC + 8);
#ifdef PROBE_A
#define STAMP(k) do { if (blockIdx.x == 0 && F.wid == 0 && lane_id() == 0) { const unsigned t_ = (unsigned)rt(); F.MISC[16 + (k)] += t_ - F.MISC[15]; F.MISC[15] = t_; } } while (0)
#else
#define STAMP(k) do { } while (0)
#endif
#ifdef PROBE_SKEW
#define ARRIVE(k, i_) do { if ((k) == PROBE_SKEW && F.wid == 0 && lane_id() == 0) { const unsigned t_ = (unsigned)rt(); atomicMax((unsigned*)(F.ctl + 24576 + 4 * (i_)), t_); atomicMax((unsigned*)(F.ctl + 24576 + 4 * (i_) + 1), ~t_); \
    atomicAdd((unsigned*)(F.ctl + 24576 + 4 * (i_) + 2), (t_ & 0xFFFFFu)); atomicMax((unsigned*)(F.ctl + 24576 + 4 * (i_) + 3), ((t_ & 0xFFFFFFu) << 8) | (unsigned)blockIdx.x); } } while (0)
#else
#define ARRIVE(k, i_) do { } while (0)
#endif
#ifdef PROBE_IDLE
#define GRID_BAR() do { XcdBarrier b_ = bar; asm volatile("" : "+s"(b_.x)); xcd_barrier(b_); for (int i_ = 0; i_ < PROBE_IDLE; ++i_) __builtin_amdgcn_s_sleep(127); } while (0)
#elif defined(PROBE_BAR2)
#define GRID_BAR() do { XcdBarrier b_ = bar; asm volatile("" : "+s"(b_.x)); xcd_barrier(b_); xcd_barrier(b_); } while (0)
#else
#define GRID_BAR() do { XcdBarrier b_ = bar; asm volatile("" : "+s"(b_.x)); xcd_barrier(b_); } while (0)
#endif

#ifdef PROBE_A
    if (blockIdx.x == 0 && F.wid == 0 && lane_id() == 0) F.MISC[15] = (unsigned)rt();
#endif
    p0a(F, true); GRID_BAR();
    if (REPS(10) == 2) { p0a(F, false); GRID_BAR(); }
    p0b(F); GRID_BAR(); STAMP(0);

#ifndef BOUSTRO
#define BOUSTRO 0
#endif
    bool dl_up = true;
    for (int f = 0; f < 2 * DEPTH; ++f) {
        const int l = f >> 1, hf = f & 1, kb = hf ? 6 : 0;
        const bool down_f = dl_up; const int g1rev = BOUSTRO ? (down_f ? 0 : 1) : 0, g2rev = BOUSTRO ? (g1rev ? 0 : 1) : 0;
        const bool ctx_ffn = (f < 2 * DEPTH - 1), ctx_mix = (l < DEPTH - 1);

        const int rprev = hf ? 3 * l + 1 : 3 * l - 1;
        for (int rep = 0; rep < REPS(1); ++rep)
        { const float* modl = P_MOD(F) + (size_t)(l * 2) * MODW;
          norm_phase<false>(F, in_ptr(F, I_NORMG) + (size_t)(l * 3 + (hf ? 2 : 0)) * DM, modl, modl + MODW, kb + 0, kb + 1, P_H(F), nullptr, ctx_ffn ? MTOT : SEQ, f <= 1 ? in_ptr(F, I_X) : P_XR(F), f == 0 ? in_ptr(F, I_CTX) : P_XR(F) + (size_t)SEQ * DM, (f == 0 || rep) ? 0 : NSLAB, (f == 0 || rep) ? 0 : ((rprev & 1) + 1), (rprev & 1) != 0, down_f);
        GRID_BAR(); } STAMP(1);
        for (int rep = 0; rep < REPS(2); ++rep)
        { pg8::Gemm g{P_H(F), P_W1(F) + (size_t)f * 2 * DFF * DM, MTOT, 2 * DFF, DM}; pg8::CtxSplitOrder S; S.init(SEQ, 2 * DFF, DM, ctx_ffn ? NSL1 : 0, F.G, (int)blockIdx.x, 0); S.rev = g1rev;
          pg8::EpiSwiGLU E{P_ACT(F), DFF, CTX_PM, P_SLAB1(F)};
          pg8::gemm_phase<pg8::EpiSwiGLU, pg8::CtxSplitOrder, G1_ALIGN, true>(F.lds + RING_OFF, g, S, E, F.wid);
        ARRIVE(2, f); GRID_BAR(); } STAMP(2);
        if (ctx_ffn) { ctx_fix_ffn(F); GRID_BAR(); } STAMP(9);
        for (int rep = 0; rep < REPS(3); ++rep)
        { const float* modl = P_MOD(F) + (size_t)(l * 2) * MODW; const float* modc = modl + MODW;
          pg8::Gemm g{P_ACT(F), P_W2(F) + (size_t)f * DM * DFF, MTOT, DM, DFF}; pg8::CtxSplitOrder S; S.init(SEQ, DM, DFF, ctx_ffn ? NSLAB : 0, F.G, (int)blockIdx.x, MINI_FIRST ? (int)((blockIdx.x & 7) >= 4) : 0); S.rev = g2rev;
          pg8::EpiDelta E{P_DL(F) + (size_t)((hf ? 3 * l + 2 : 3 * l) & 1) * SEQ * DM, DM, modl + (kb + 2) * DM, modc + (kb + 2) * DM, CTX_PM, 0.5f, P_SLAB(F)};
          pg8::gemm_phase<pg8::EpiDelta, pg8::CtxSplitOrder, RESID_ALIGN, true>(F.lds + RING_OFF, g, S, E, F.wid);
        GRID_BAR(); } STAMP(3);
        dl_up = (g2rev == 0);
        if (hf == 0) {
            for (int rep = 0; rep < REPS(1); ++rep)
            { const float* modl = P_MOD(F) + (size_t)(l * 2) * MODW;
              norm_phase<false>(F, in_ptr(F, I_NORMG) + (size_t)(l * 3 + 1) * DM, modl, modl + MODW, 3, 4, P_H(F), nullptr, MTOT, l == 0 ? in_ptr(F, I_X) : P_XR(F), l == 0 ? in_ptr(F, I_CTX) : P_XR(F) + (size_t)SEQ * DM, rep ? 0 : NSLAB, rep ? 0 : (((3 * l) & 1) + 1), ((3 * l) & 1) != 0, dl_up);
            GRID_BAR(); } STAMP(1);
            for (int rep = 0; rep < REPS(4); ++rep)
            { pg8::Gemm g{P_H(F), P_WMI(F) + (size_t)l * INC * DM, MTOT, INC, DM}; pg8::CtxSplitOrder S; S.init(SEQ, INC, DM, NSL2, F.G, (int)blockIdx.x, 0); S.rev = GEMM_REV; S.ord = INPROJ_COLMAJOR;
              pg8::EpiStoreBf16 E{P_PROJ(F), INC, CTX_PM, P_SLAB2(F)};
              pg8::gemm_phase<pg8::EpiStoreBf16, pg8::CtxSplitOrder, true, true>(F.lds + RING_OFF, g, S, E, F.wid);
            GRID_BAR(); } STAMP(4);
            ctx_fix_proj(F); GRID_BAR(); STAMP(10);
            for (int rep = 0; rep < REPS(5); ++rep) {
            for (int nu_ = ((ctx_mix ? MTOT : SEQ) / 128) * 8, u = F.vcu + ((nu_ - 1 - F.vcu) / F.G) * F.G; u >= 0; u -= F.G)
#ifndef NO_SGU
                sgu_unit(F, u >> 3, u & 7, in_ptr(F, I_SGUG) + (size_t)l * 1024, in_ptr(F, I_SGUW) + (size_t)l * 8 * 128 * 128, in_ptr(F, I_SGUB) + (size_t)l * 8 * 128);
#else
                ;
#endif
#ifndef NO_QKN
            if (rep == 0) { const bool fast = attn_noshift_ok(in_ptr(F, I_QKG) + (size_t)l * 256);
                qknorm_rows(F, in_ptr(F, I_QKG) + (size_t)l * 256, fast); }
#endif
            for (int u = F.vcu; u < 512; u += F.G) {
                const bf16* const PROJ = P_PROJ(F); bf16* const CAT = P_CAT(F);
                const int h = u >> 6, blk = u & 63; int lo = 4 * blk - 4; lo = lo < 0 ? 0 : (lo > 244 ? 244 : lo);
                const int wv = F.wid;
                att::NbArgs nb{lo, 4 * blk + (wv >> 1), 32 * (wv & 1) + (lane_id() & 31), in_ptr(F, I_RPB) + (size_t)(l * 8 + h) * 15 * 31, nullptr, nullptr, 0};
#ifndef NO_ATT1
                att::attn_unit<1, INC, INC, DM, ATT1_SDEPTH>(PROJ + (size_t)(blk * 256) * INC + C_QB + h * 128, PROJ + C_KB + h * 128, PROJ + C_VB + h * 128,
                                                CAT + (size_t)(blk * 256) * DM + O_B + h * 128, 0, 16, (char*)lds + RING_OFF, nb, F.wid);
#endif
            }
            GRID_BAR(); } STAMP(5);
            {
            const bool fast = attn_noshift_ok(in_ptr(F, I_QKG) + (size_t)l * 256);
            if (fast)
            for (int u_ = F.vcu; u_ < 1024 * REPS(6); u_ += F.G) { const int u = u_ & 1023;
                const bf16* const PROJ = P_PROJ(F); bf16* const CAT = P_CAT(F);
                const int h = u >> 6, blk = u & 63, kvh = h >> 2;
                att::NbArgs nb{0, 0, 0, nullptr, in_ptr(F, I_QKG) + (size_t)l * 256, P_ROPE(F), blk * 256};
#ifndef NO_ATT0
                att::attn_unit<0, INC, INC, DM, ATT0_SDEPTH>(PROJ + (size_t)(blk * 256) * INC + C_QA + h * 128, PROJ + C_KA + kvh * 128, PROJ + C_VA + kvh * 128,
                                                             CAT + (size_t)(blk * 256) * DM + O_A + h * 128, 0, MTOT / 64, (char*)lds + RING_OFF, nb, F.wid);
#endif
#ifdef A_ROUND_BAR
                if (1024 % F.G == 0 && u_ + F.G < 1024) GRID_BAR();
#endif
            }
            const int nmain2 = fast ? 0 : 1024;
            for (int u = F.vcu; u < nmain2 + (ctx_mix ? 16 + 8 : 0); u += F.G) {
                const bf16* const PROJ = P_PROJ(F); bf16* const CAT = P_CAT(F);
                att::NbArgs nb{0, 0, 0, nullptr, nullptr, nullptr, 0};
                int qrow, qc, kc, vc, oc, kb, nt;
                if (u < nmain2) { const int h = u >> 6, blk = u & 63; qrow = blk * 256; qc = C_QA + h * 128; kc = C_KA + (h >> 2) * 128; vc = C_VA + (h >> 2) * 128; oc = O_A + h * 128; kb = 0; nt = MTOT / 64; }
                else { const int uu = u - nmain2; const bool ga = uu < 16; const int h = ga ? uu : uu - 16; qrow = SEQ; qc = (ga ? C_QA : C_QB) + h * 128; kc = ga ? C_KA + (h >> 2) * 128 : C_KB + h * 128;
                       vc = ga ? C_VA + (h >> 2) * 128 : C_VB + h * 128; oc = (ga ? O_A : O_B) + h * 128; kb = SEQ; nt = CTXL / 64; }
                att::attn_unit<2, INC, INC, DM, 1>(PROJ + (size_t)qrow * INC + qc, PROJ + kc, PROJ + vc, CAT + (size_t)qrow * DM + oc, kb, nt, (char*)lds + RING_OFF, nb, F.wid);
            }
            ARRIVE(6, l); GRID_BAR(); } STAMP(6);
            for (int rep = 0; rep < REPS(7); ++rep)
            { const float* modl = P_MOD(F) + (size_t)(l * 2) * MODW; const float* modc = modl + MODW;
              pg8::Gemm g{P_CAT(F), P_WMO(F) + (size_t)l * DM * DM, MTOT, DM, DM}; pg8::CtxSplitOrder S; S.init(SEQ, DM, DM, ctx_mix ? NSLAB : 0, F.G, (int)blockIdx.x, MINI_FIRST ? (int)((blockIdx.x & 7) >= 4) : 0);
              pg8::EpiDelta E{P_DL(F) + (size_t)((3 * l + 1) & 1) * SEQ * DM, DM, modl + 5 * DM, modc + 5 * DM, CTX_PM, 1.0f, P_SLAB(F)};
              pg8::gemm_phase<pg8::EpiDelta, pg8::CtxSplitOrder, RESID_ALIGN, true>(F.lds + RING_OFF, g, S, E, F.wid);
            GRID_BAR(); } STAMP(7);
            dl_up = true;
        }
    }
    norm_phase<true>(F, in_ptr(F, I_FING), nullptr, nullptr, 0, 0, nullptr, F.out, SEQ, P_XR(F), P_XR(F), 0, 2, false, dl_up);
    if (__hip_atomic_load((gu32*)((unsigned*)(F.ctl + CW_BAR) + XB_TMO), RLX_AGENT) != 0u) {
        int tl_ = threadIdx.x; asm volatile("" : "+v"(tl_));
        const int gw = F.vcu * NWAVES + F.wid, NGW = F.G * NWAVES; const float qn = __builtin_nanf("");
        for (int m = gw; m < SEQ; m += NGW) { GAS f32x4* o = (GAS f32x4*)(F.out + (size_t)m * DM) + (tl_ & 63);
#pragma unroll
            for (int j = 0; j < 16; ++j) o[64 * j] = (f32x4){qn, qn, qn, qn}; }
    }
#ifdef PROBE_A
    GRID_BAR(); STAMP(8);
    if (blockIdx.x == 0 && F.wid == 0) { const unsigned span = F.MISC[16 + PROBE_A] * (unsigned)PROBE_MUL; const unsigned t0 = (unsigned)rt(); while ((unsigned)rt() - t0 < span) __builtin_amdgcn_s_sleep(100); }
#endif
#ifdef PROBE_SKEW
    GRID_BAR();
    if (blockIdx.x == 0 && F.wid == 0) { unsigned span = 0; for (int i = 0; i < 8; ++i) { const unsigned a = __hip_atomic_load((gu32*)(F.ctl + 24576 + 4 * i), RLX_AGENT), b = ~__hip_atomic_load((gu32*)(F.ctl + 24576 + 4 * i + 1), RLX_AGENT);
            const unsigned sm = __hip_atomic_load((gu32*)(F.ctl + 24576 + 4 * i + 2), RLX_AGENT), who = __hip_atomic_load((gu32*)(F.ctl + 24576 + 4 * i + 3), RLX_AGENT) & 255u;
            if (a != 0u) {
                if (PROBE_WHAT == 0) span += (a - b) * (unsigned)PROBE_MUL;
                else if (PROBE_WHAT == 1) { const unsigned base = b & ~0xFFFFFu; const unsigned mean = (unsigned)(((unsigned long long)sm + ((b & 0xFFFFFu) > (a & 0xFFFFFu) ? 0u : 0u)) / (unsigned)F.G); span += ((a & 0xFFFFFu) - mean) * (unsigned)PROBE_MUL; (void)base; }
                else if (i == PROBE_WHICH) span += (PROBE_WHAT == 2 ? (who & 7u) * 50000u + (who >> 3) * 1000u : 0u);
            } }
        const unsigned t0 = (unsigned)rt(); while ((unsigned)rt() - t0 < span) __builtin_amdgcn_s_sleep(100); }
#endif
}

extern "C" void kernel_launch(void* const* d_in, const int* in_sizes, int n_in, void* d_out, int out_size, void* d_ws, size_t ws_size, hipStream_t stream) {
    static int grid = 0;
    if (grid == 0) {
        if (n_in != 18 || in_sizes[0] != SEQ * DM || out_size != SEQ * DM || ws_size < WS_END) {
            fprintf(stderr, "kernel_launch: built for 18 inputs, x/out of %d floats, >= %zu bytes of workspace; got n_in %d, in0 %d, out %d, ws %zu; nothing launched\n", SEQ * DM, (size_t)WS_END, n_in, n_in > 0 ? in_sizes[0] : -1, out_size, ws_size);
            grid = -1; return; }
        int dev = 0, cus = 0, per_cu = 0;
        if (hipGetDevice(&dev) != hipSuccess || hipDeviceGetAttribute(&cus, hipDeviceAttributeMultiprocessorCount, dev) != hipSuccess) { fprintf(stderr, "kernel_launch: device query failed\n"); grid = -1; return; }
        if (hipFuncSetAttribute((const void*)dit_fwd, hipFuncAttributeMaxDynamicSharedMemorySize, LDS_BYTES) != hipSuccess) { fprintf(stderr, "kernel_launch: hipFuncSetAttribute failed\n"); grid = -1; return; }
        if (hipOccupancyMaxActiveBlocksPerMultiprocessor(&per_cu, (const void*)dit_fwd, NWAVES * 64, LDS_BYTES) != hipSuccess || per_cu < 1)
            fprintf(stderr, "kernel_launch: note: occupancy query reports %d workgroups per CU\n", per_cu);
        (void)hipGetLastError();
        grid = cus;
    }
    if (grid < 0) return;
    if (hipMemsetAsync((char*)d_ws + WS_CTL, 0, CTL_ZERO_BYTES, stream) != hipSuccess) { fprintf(stderr, "kernel_launch: hipMemsetAsync failed\n"); return; }
    Args a{};
    for (int i = 0; i < 18; ++i) a.in[i] = (const float*)d_in[i];
    a.out = (float*)d_out; a.ws = (unsigned char*)d_ws;
    hipLaunchKernelGGL(dit_fwd, dim3(grid), dim3(NWAVES * 64), LDS_BYTES, stream, a);
    const hipError_t le = hipPeekAtLastError();
    if (le != hipSuccess) fprintf(stderr, "kernel_launch: launch failed: %s\n", hipGetErrorName(le));
}
```
